# Optimizing an MI355X kernel written in HIP

```python
import numpy as np
import jax, jax.numpy as jnp
from jax import lax

D_MODEL = 1024
BATCH = 8
SEQ = 2048
DEPTH = 4

HEAD_DIM = 64
ROPE_THETA = 10000.0
RMS_EPS = 1e-6
A_HEADS = 8
A_KV = 1
A_WINDOW = 128
A_QBLOCK = 128
B_HEADS = 8
B_KV = 2
CMP_LEN = 32
CMP_STRIDE = 16
CMP_HIDDEN = 256
SLC_LEN = 64
SLC_TOPN = 8
WIN_LEN = 512
B_QBLOCK = 128
FORCE_BONUS = 1e4
C_HEADS = 16
MOBA_BLOCK = 256
MOBA_TOPK = 3
C_QBLOCK = 32

A_QW = A_HEADS * HEAD_DIM
A_KVW = A_KV * HEAD_DIM
B_QW = B_HEADS * HEAD_DIM
B_KVW = B_KV * HEAD_DIM
B_GATEW = 3 * B_HEADS
C_W = C_HEADS * HEAD_DIM
EVEN_SIZES = (A_QW, A_KVW, A_KVW, A_QW, B_QW, B_KVW, B_KVW, B_KVW, B_KVW, B_KVW, B_KVW, B_GATEW, B_QW)
EVEN_WIDTH = A_QW + 2 * A_KVW + A_QW + B_QW + 6 * B_KVW + B_GATEW + B_QW
EVEN_OUT = A_QW + B_QW
ODD_SIZES = (C_W, C_W, C_W, C_W)
ODD_WIDTH = 4 * C_W
N_EVEN = (DEPTH + 1) // 2
N_ODD = DEPTH // 2

kernel_name = "hybrid_swa_nsa_moba_adaln_trunk"


def _offsets(sizes):
    out, acc = [], 0
    for s in sizes[:-1]:
        acc += s
        out.append(acc)
    return out


def rms_norm(x, g):
    xf = x.astype(jnp.float32)
    y = xf * lax.rsqrt(jnp.mean(xf * xf, axis=-1, keepdims=True) + RMS_EPS)
    return (y * g.astype(jnp.float32)).astype(x.dtype)


def rope_tables(n):
    inv = ROPE_THETA ** (-jnp.arange(0, HEAD_DIM, 2, dtype=jnp.float32) / HEAD_DIM)
    ang = jnp.arange(n, dtype=jnp.float32)[:, None] * inv[None, :]
    return jnp.cos(ang), jnp.sin(ang)


def apply_rope(x, cos, sin):
    half = HEAD_DIM // 2
    xf = x.astype(jnp.float32)
    x1, x2 = xf[..., :half], xf[..., half:]
    return jnp.concatenate([x1 * cos - x2 * sin, x2 * cos + x1 * sin], axis=-1).astype(x.dtype)


def split_heads(t, n):
    b, s, _ = t.shape
    return t.reshape(b, s, n, HEAD_DIM).transpose(0, 2, 1, 3)


def merge_heads(o):
    b, h, s, d = o.shape
    return o.transpose(0, 2, 1, 3).reshape(b, s, h * d)


def masked_softmax(s, mask, sink=None):
    s = jnp.where(mask, s, -jnp.inf)
    m = jnp.max(s, axis=-1, keepdims=True)
    if sink is not None:
        m = jnp.maximum(m, sink)
    m = jnp.where(jnp.isfinite(m), m, 0.0)
    e = jnp.where(mask, jnp.exp(s - m), 0.0)
    den = jnp.sum(e, axis=-1, keepdims=True)
    if sink is not None:
        den = den + jnp.exp(sink - m)
    return e / jnp.where(den > 0, den, 1.0)


def gather_blocks(kb, idx):
    return jax.vmap(jax.vmap(lambda a, i: a[i]))(kb, idx)


def banded_attention(q, k, v, window, block, sink=None):
    b, g, r, s, d = q.shape
    nb = s // block
    n_prev = -(-(window - 1) // block)
    span = (n_prev + 1) * block
    pad = n_prev * block
    kp = jnp.pad(k, ((0, 0), (0, 0), (pad, 0), (0, 0)))
    vp = jnp.pad(v, ((0, 0), (0, 0), (pad, 0), (0, 0)))
    idx = np.arange(nb)[:, None] * block + np.arange(span)[None, :]
    kb = kp[:, :, idx]
    vb = vp[:, :, idx]
    qb = q.reshape(b, g, r, nb, block, d)
    sc = jnp.einsum('bgrnqd,bgnkd->bgrnqk', qb, kb).astype(jnp.float32) * (HEAD_DIM ** -0.5)
    qpos = np.arange(nb)[:, None] * block + np.arange(block)[None, :]
    kpos = idx - pad
    diff = qpos[:, :, None] - kpos[:, None, :]
    mask = jnp.asarray((diff >= 0) & (diff < window) & (kpos[:, None, :] >= 0))
    sk = None if sink is None else sink.astype(jnp.float32).reshape(1, g, r, 1, 1, 1)
    p = masked_softmax(sc, mask, sk)
    o = jnp.einsum('bgrnqk,bgnkd->bgrnqd', p.astype(v.dtype), vb)
    return o.reshape(b, g, r, s, d)


def swa_sink_attention(qa, ka, va, sinks, cos, sin):
    b, s, _ = qa.shape
    q = apply_rope(split_heads(qa, A_HEADS), cos, sin).reshape(b, A_KV, A_HEADS // A_KV, s, HEAD_DIM)
    k = apply_rope(split_heads(ka, A_KV), cos, sin)
    v = split_heads(va, A_KV)
    o = banded_attention(q, k, v, A_WINDOW, A_QBLOCK, sinks.reshape(A_KV, A_HEADS // A_KV))
    return merge_heads(o.reshape(b, A_HEADS, s, HEAD_DIM))


def compress_mlp(blocks, pe, w1, w2):
    b, g, nc, l, d = blocks.shape
    u = (blocks + pe).reshape(b, g, nc, l * d)
    return jax.nn.gelu(u @ w1) @ w2


def nsa_attention(qb, kc, vc, ks, vs, kw, vw, gl, pe_k, w1k, w2k, pe_v, w1v, w2v, cos, sin):
    b, s, _ = qb.shape
    rr = B_HEADS // B_KV
    scale = HEAD_DIM ** -0.5
    q = apply_rope(split_heads(qb, B_HEADS), cos, sin).reshape(b, B_KV, rr, s, HEAD_DIM)
    kc = apply_rope(split_heads(kc, B_KV), cos, sin)
    ks = apply_rope(split_heads(ks, B_KV), cos, sin)
    kw = apply_rope(split_heads(kw, B_KV), cos, sin)
    vc, vs, vw = split_heads(vc, B_KV), split_heads(vs, B_KV), split_heads(vw, B_KV)

    nc = (s - CMP_LEN) // CMP_STRIDE + 1
    cidx = np.arange(nc)[:, None] * CMP_STRIDE + np.arange(CMP_LEN)[None, :]
    k_cmp = compress_mlp(kc[:, :, cidx], pe_k, w1k, w2k)
    v_cmp = compress_mlp(vc[:, :, cidx], pe_v, w1v, w2v)
    sc = jnp.einsum('bgrsd,bgcd->bgrsc', q, k_cmp).astype(jnp.float32) * scale
    mask_c = jnp.asarray(np.arange(s)[:, None] >= cidx[None, :, -1])
    p_cmp = masked_softmax(sc, mask_c)
    o_cmp = jnp.einsum('bgrsc,bgcd->bgrsd', p_cmp.astype(v_cmp.dtype), v_cmp)

    nsb = s // SLC_LEN
    cst = cidx[:, 0]
    jj = np.arange(nsb)
    overlap = ((cst[:, None] < (jj[None, :] + 1) * SLC_LEN) & (cst[:, None] + CMP_LEN > jj[None, :] * SLC_LEN)).astype(np.float32)
    imp = jnp.einsum('bgrsc,cj->bgsj', p_cmp, jnp.asarray(overlap))
    tb = np.arange(s)[:, None] // SLC_LEN
    valid = jnp.asarray(jj[None, :] <= tb)
    forced = jnp.asarray((jj[None, :] == 0) | (jj[None, :] == tb) | (jj[None, :] == tb - 1))
    score = jnp.where(valid, jnp.where(forced, FORCE_BONUS, imp), -jnp.inf)
    top_s, top_i = lax.top_k(score, min(SLC_TOPN, nsb))
    sel_ok = top_s > -jnp.inf
    n_sel = top_i.shape[-1]
    ksb = ks.reshape(b, B_KV, nsb, SLC_LEN, HEAD_DIM)
    vsb = vs.reshape(b, B_KV, nsb, SLC_LEN, HEAD_DIM)

    def sel_chunk(ci):
        start = ci * B_QBLOCK
        qc = lax.dynamic_slice_in_dim(q, start, B_QBLOCK, axis=3)
        ic = lax.dynamic_slice_in_dim(top_i, start, B_QBLOCK, axis=2)
        okc = lax.dynamic_slice_in_dim(sel_ok, start, B_QBLOCK, axis=2)
        kg = gather_blocks(ksb, ic)
        vg = gather_blocks(vsb, ic)
        sc_ = jnp.einsum('bgrqd,bgqnkd->bgrqnk', qc, kg).astype(jnp.float32) * scale
        tpos = start + jnp.arange(B_QBLOCK)
        kpos = ic[..., None] * SLC_LEN + jnp.arange(SLC_LEN)
        msk = okc[..., None] & (kpos <= tpos[None, None, :, None, None])
        m_tot = n_sel * SLC_LEN
        p = masked_softmax(sc_.reshape(b, B_KV, rr, B_QBLOCK, m_tot), msk.reshape(b, B_KV, 1, B_QBLOCK, m_tot))
        return jnp.einsum('bgrqm,bgqmd->bgrqd', p.astype(vg.dtype), vg.reshape(b, B_KV, B_QBLOCK, m_tot, HEAD_DIM))

    o_slc = lax.map(sel_chunk, jnp.arange(s // B_QBLOCK))
    o_slc = o_slc.transpose(1, 2, 3, 0, 4, 5).reshape(b, B_KV, rr, s, HEAD_DIM)

    o_win = banded_attention(q, kw, vw, WIN_LEN, B_QBLOCK)

    g = jax.nn.sigmoid(gl.astype(jnp.float32)).reshape(b, s, B_KV, rr, 3).transpose(0, 2, 3, 1, 4).astype(q.dtype)
    o = g[..., 0:1] * o_cmp + g[..., 1:2] * o_slc + g[..., 2:3] * o_win
    return merge_heads(o.reshape(b, B_HEADS, s, HEAD_DIM))


def moba_attention(qc_, kc_, vc_, cos, sin):
    b, s, _ = qc_.shape
    scale = HEAD_DIM ** -0.5
    q = apply_rope(split_heads(qc_, C_HEADS), cos, sin)
    k = apply_rope(split_heads(kc_, C_HEADS), cos, sin)
    v = split_heads(vc_, C_HEADS)
    sp = -(-s // MOBA_BLOCK) * MOBA_BLOCK
    padw = ((0, 0), (0, 0), (0, sp - s), (0, 0))
    q, k, v = jnp.pad(q, padw), jnp.pad(k, padw), jnp.pad(v, padw)
    nblk = sp // MOBA_BLOCK
    kb = k.reshape(b, C_HEADS, nblk, MOBA_BLOCK, HEAD_DIM)
    vb = v.reshape(b, C_HEADS, nblk, MOBA_BLOCK, HEAD_DIM)
    kmean = jnp.mean(kb.astype(jnp.float32), axis=3)
    gs = jnp.einsum('bhsd,bhjd->bhsj', q.astype(jnp.float32), kmean)
    past = jnp.asarray(np.arange(nblk)[None, :] < (np.arange(sp) // MOBA_BLOCK)[:, None])
    gs = jnp.where(past, gs, -jnp.inf)
    top_s, top_i = lax.top_k(gs, min(MOBA_TOPK, nblk))
    ok = top_s > -jnp.inf
    n_sel = top_i.shape[-1]

    def chunk(ci):
        start = ci * C_QBLOCK
        qc = lax.dynamic_slice_in_dim(q, start, C_QBLOCK, axis=2)
        ic = lax.dynamic_slice_in_dim(top_i, start, C_QBLOCK, axis=2)
        okc = lax.dynamic_slice_in_dim(ok, start, C_QBLOCK, axis=2)
        kg = gather_blocks(kb, ic)
        vg = gather_blocks(vb, ic)
        s_sel = jnp.einsum('bhqd,bhqnkd->bhqnk', qc, kg).astype(jnp.float32).reshape(b, C_HEADS, C_QBLOCK, n_sel * MOBA_BLOCK)
        own = (start // MOBA_BLOCK) * MOBA_BLOCK
        kown = lax.dynamic_slice_in_dim(k, own, MOBA_BLOCK, axis=2)
        vown = lax.dynamic_slice_in_dim(v, own, MOBA_BLOCK, axis=2)
        s_own = jnp.einsum('bhqd,bhkd->bhqk', qc, kown).astype(jnp.float32)
        tpos = start + jnp.arange(C_QBLOCK)
        m_own = (own + jnp.arange(MOBA_BLOCK))[None, :] <= tpos[:, None]
        m_sel = jnp.repeat(okc, MOBA_BLOCK, axis=-1)
        mask = jnp.concatenate([m_sel, jnp.broadcast_to(m_own, (b, C_HEADS, C_QBLOCK, MOBA_BLOCK))], axis=-1)
        p = masked_softmax(jnp.concatenate([s_sel, s_own], axis=-1) * scale, mask).astype(v.dtype)
        nk = n_sel * MOBA_BLOCK
        o = jnp.einsum('bhqm,bhqmd->bhqd', p[..., :nk], vg.reshape(b, C_HEADS, C_QBLOCK, nk, HEAD_DIM))
        return o + jnp.einsum('bhqk,bhkd->bhqd', p[..., nk:], vown)

    o = lax.map(chunk, jnp.arange(sp // C_QBLOCK))
    o = o.transpose(1, 2, 0, 3, 4).reshape(b, C_HEADS, sp, HEAD_DIM)[:, :, :s]
    return merge_heads(o)


def even_mixer(h, w_in, w_out, sinks, pe_k, w1k, w2k, pe_v, w1v, w2v, cos, sin):
    proj = jnp.einsum('bsd,de->bse', h, w_in)
    qa, ka, va, za, qb, kc, vc, ks, vs, kw, vw, gb, zb = jnp.split(proj, _offsets(EVEN_SIZES), axis=-1)
    oa = swa_sink_attention(qa, ka, va, sinks, cos, sin) * jax.nn.silu(za)
    ob = nsa_attention(qb, kc, vc, ks, vs, kw, vw, gb, pe_k, w1k, w2k, pe_v, w1v, w2v, cos, sin) * jax.nn.silu(zb)
    return jnp.einsum('bse,ed->bsd', jnp.concatenate([oa, ob], axis=-1), w_out)


def odd_mixer(h, w_in, w_out, cos, sin):
    proj = jnp.einsum('bsd,de->bse', h, w_in)
    q, k, v, z = jnp.split(proj, _offsets(ODD_SIZES), axis=-1)
    o = moba_attention(q, k, v, cos, sin) * jax.nn.silu(z)
    return jnp.einsum('bse,ed->bsd', o, w_out)


def setup_inputs(seed: int = 0) -> dict:
    key = jax.random.key(seed)
    ks = jax.random.split(key, 20)
    nrm = lambda k, shape, sc: jax.random.normal(k, shape, jnp.float32) * sc
    d = D_MODEL
    fl = CMP_LEN * HEAD_DIM
    return {
        "x": nrm(ks[0], (BATCH, SEQ, d), 1.0),
        "c": nrm(ks[1], (BATCH, d), 1.0),
        "w_ada": nrm(ks[2], (DEPTH, d, 3 * d), 0.5 * d ** -0.5),
        "b_ada": nrm(ks[3], (DEPTH, 3 * d), 0.01),
        "norm_g": 1.0 + nrm(ks[4], (DEPTH, d), 0.02),
        "w_in_even": nrm(ks[5], (N_EVEN, d, EVEN_WIDTH), d ** -0.5),
        "a_sinks": nrm(ks[6], (N_EVEN, A_HEADS), 0.5),
        "cmp_pe_k": nrm(ks[7], (N_EVEN, CMP_LEN, HEAD_DIM), 0.1),
        "cmp_w1_k": nrm(ks[8], (N_EVEN, fl, CMP_HIDDEN), fl ** -0.5),
        "cmp_w2_k": nrm(ks[9], (N_EVEN, CMP_HIDDEN, HEAD_DIM), CMP_HIDDEN ** -0.5),
        "cmp_pe_v": nrm(ks[10], (N_EVEN, CMP_LEN, HEAD_DIM), 0.1),
        "cmp_w1_v": nrm(ks[11], (N_EVEN, fl, CMP_HIDDEN), fl ** -0.5),
        "cmp_w2_v": nrm(ks[12], (N_EVEN, CMP_HIDDEN, HEAD_DIM), CMP_HIDDEN ** -0.5),
        "w_out_even": nrm(ks[13], (N_EVEN, EVEN_OUT, d), EVEN_OUT ** -0.5),
        "w_in_odd": nrm(ks[14], (N_ODD, d, ODD_WIDTH), d ** -0.5),
        "w_out_odd": nrm(ks[15], (N_ODD, C_W, d), C_W ** -0.5),
        "final_g": 1.0 + nrm(ks[16], (d,), 0.02),
    }


def reference(x, c, w_ada, b_ada, norm_g, w_in_even, a_sinks, cmp_pe_k, cmp_w1_k, cmp_w2_k,
              cmp_pe_v, cmp_w1_v, cmp_w2_v, w_out_even, w_in_odd, w_out_odd, final_g):
    cos, sin = rope_tables(x.shape[1])
    c_act = jax.nn.silu(c)
    for layer in range(DEPTH):
        ada = jnp.einsum('bd,de->be', c_act, w_ada[layer]) + b_ada[layer]
        shift, scale, gate = jnp.split(ada, 3, axis=-1)
        h = rms_norm(x, norm_g[layer]) * (1.0 + scale[:, None, :]) + shift[:, None, :]
        i = layer // 2
        if layer % 2 == 0:
            y = even_mixer(h, w_in_even[i], w_out_even[i], a_sinks[i], cmp_pe_k[i], cmp_w1_k[i], cmp_w2_k[i],
                           cmp_pe_v[i], cmp_w1_v[i], cmp_w2_v[i], cos, sin)
        else:
            y = odd_mixer(h, w_in_odd[i], w_out_odd[i], cos, sin)
        x = x + gate[:, None, :] * y
    return rms_norm(x, final_g)
```

```cpp
#include <hip/hip_runtime.h>
#include <hip/hip_cooperative_groups.h>
#include <stdint.h>
#include <stdio.h>
namespace cg = cooperative_groups;

#ifndef FUSED
#define FUSED 1
#endif
#ifndef PROBE_DUP
#define PROBE_DUP 0
#endif
#ifndef MINW
#define MINW 2
#endif

typedef unsigned short bf16_t;
typedef short bf16x8 __attribute__((ext_vector_type(8)));
typedef float f32x16 __attribute__((ext_vector_type(16)));
typedef unsigned u32x4 __attribute__((ext_vector_type(4)));
typedef float f32x4 __attribute__((ext_vector_type(4)));
#define DI __device__ __forceinline__
#define MFMA(a, b, c) __builtin_amdgcn_mfma_f32_32x32x16_bf16((a), (b), (c), 0, 0, 0)
#define NEG_INF (-__builtin_inff())

constexpr int S_ = 2048, T_ = 16384;
constexpr float SC2 = 0.125f * 1.44269504088896f;
constexpr float LOG2E = 1.44269504088896f;

constexpr size_t MBy = 1u << 20;
constexpr size_t OFF_H = 0;
constexpr size_t OFF_PROJ = 32 * MBy;
constexpr size_t OFF_WIE = 160 * MBy;
constexpr size_t OFF_WIO = 172 * MBy;
constexpr size_t OFF_WOE = 188 * MBy;
constexpr size_t OFF_WOO = 192 * MBy;
constexpr size_t OFF_W1 = 196 * MBy;
constexpr size_t OFF_W2 = 200 * MBy;
constexpr size_t OFF_ADA = 201 * MBy;
constexpr size_t OFF_ROPE = 204 * MBy;
constexpr size_t OFF_PEB = 205 * MBy;
constexpr size_t OFF_HID = 206 * MBy;
constexpr size_t OFF_KCMP = 208 * MBy;
constexpr size_t OFF_VCMPT = 208 * MBy + 512 * 1024;
constexpr size_t OFF_KMEAN = 209 * MBy;
constexpr size_t OFF_BAR = 210 * MBy;
constexpr size_t OFF_A2 = 212 * MBy;
constexpr size_t OFF_ROWSS = 245 * MBy;
constexpr size_t OFF_GG = 246 * MBy;
constexpr size_t OFF_BIAS = 247 * MBy;
constexpr size_t OFF_PART = OFF_PROJ + 96 * MBy;
constexpr size_t OFF_PEBF = OFF_PEB + 512 * 1024;
constexpr size_t E_QA = OFF_PROJ, E_ZA = OFF_PROJ + 16 * MBy, E_QB = OFF_PROJ + 32 * MBy, E_ZB = OFF_PROJ + 48 * MBy;
constexpr size_t E_KA = OFF_PROJ + 64 * MBy, E_VAT = OFF_PROJ + 66 * MBy, E_KC = OFF_PROJ + 68 * MBy, E_VC = OFF_PROJ + 72 * MBy;
constexpr size_t E_KS = OFF_PROJ + 76 * MBy, E_VST = OFF_PROJ + 80 * MBy, E_KW = OFF_PROJ + 84 * MBy, E_VWT = OFF_PROJ + 88 * MBy;
constexpr size_t E_GB = OFF_PROJ + 92 * MBy;
constexpr size_t O_Q = OFF_PROJ, O_K = OFF_PROJ + 32 * MBy, O_VT = OFF_PROJ + 64 * MBy, O_Z = OFF_PROJ + 96 * MBy;

struct Params {
  const float *x, *c, *w_ada, *b_ada, *norm_g, *w_in_even, *a_sinks, *pe_k, *w1k, *w2k, *pe_v, *w1v, *w2v, *w_out_even, *w_in_odd, *w_out_odd, *final_g;
  float* out;
  char* ws;
};

typedef __bf16 bf16v2 __attribute__((ext_vector_type(2)));
DI unsigned pk2(float lo, float hi) { bf16v2 v = {(__bf16)lo, (__bf16)hi}; return __builtin_bit_cast(unsigned, v); }
DI unsigned f2bf(float x) { return pk2(x, 0.f) & 0xffffu; }
DI float bf2f(unsigned b) { return __uint_as_float(b << 16); }
DI float bflo(unsigned u) { return __uint_as_float(u << 16); }
DI float bfhi(unsigned u) { return __uint_as_float(u & 0xffff0000u); }
DI int tidx() { int t = (int)__builtin_amdgcn_workitem_id_x(); asm volatile("" : "+v"(t)); return t; }
DI int crow(int r, int h) { return (r & 3) + 8 * (r >> 2) + 4 * h; }
DI float siluf(float z) { return z / (1.f + __expf(-z)); }
DI float ex2(float x) { return __builtin_amdgcn_exp2f(x); }

template <class ARow, class Epi>
DI void gemm_tiles(char* smem, const bf16_t* __restrict__ A, ARow arow, const bf16_t* __restrict__ Wt, int ldb, int K, int MT, int NT,
                   int vb, int nb, Epi epi, bool xcd_order = false) {
  bf16_t* As = (bf16_t*)smem;
  bf16_t* Bs = As + 128 * 72;
  const int tid = tidx(), lane = tid & 63, w = tid >> 6, wm = w >> 1, wn = w & 1;
  const int lr = tid >> 3, lc = (tid & 7) * 8;
  const int KT = K >> 6;
  const int i = lane & 31, h = lane >> 5;
  const bool xo = xcd_order && ((nb & 7) == 0) && ((MT & 7) == 0);
  const int t_start = xo ? (vb >> 3) : vb, t_step = xo ? (nb >> 3) : nb, t_total = xo ? (MT >> 3) * NT : MT * NT;
  for (int tile = t_start; tile < t_total; tile += t_step) {
    int tm, tn;
    if (xo) { const int gsz = 8 * NT, gid = tile / gsz, wi = tile - gid * gsz; tm = (vb & 7) * (MT >> 3) + gid * 8 + (wi & 7); tn = wi >> 3; }
    else { tm = tile / NT; tn = tile - tm * NT; }
    const bf16_t* ap0 = A + arow(tm * 128 + lr) + lc;
    const size_t astep = arow(tm * 128 + 32 + lr) - arow(tm * 128 + lr);
    const bf16_t* bp = Wt + (size_t)(tn * 256 + lr) * ldb + lc;
    const size_t bstep = (size_t)32 * ldb;
    u32x4 ra0, ra1, ra2, ra3, rb0, rb1, rb2, rb3, rb4, rb5, rb6, rb7;
#define GLOAD(ko)                                                                                         \
    ra0 = *(const u32x4*)(ap0 + (ko)); ra1 = *(const u32x4*)(ap0 + astep + (ko));                         \
    ra2 = *(const u32x4*)(ap0 + 2 * astep + (ko)); ra3 = *(const u32x4*)(ap0 + 3 * astep + (ko));         \
    rb0 = *(const u32x4*)(bp + (ko)); rb1 = *(const u32x4*)(bp + bstep + (ko));                           \
    rb2 = *(const u32x4*)(bp + 2 * bstep + (ko)); rb3 = *(const u32x4*)(bp + 3 * bstep + (ko));           \
    rb4 = *(const u32x4*)(bp + 4 * bstep + (ko)); rb5 = *(const u32x4*)(bp + 5 * bstep + (ko));           \
    rb6 = *(const u32x4*)(bp + 6 * bstep + (ko)); rb7 = *(const u32x4*)(bp + 7 * bstep + (ko));
    GLOAD(0)
    f32x16 acc[2][2][2];
#pragma unroll
    for (int a = 0; a < 2; ++a)
#pragma unroll
      for (int b = 0; b < 2; ++b)
#pragma unroll
        for (int c = 0; c < 2; ++c)
#pragma unroll
          for (int r = 0; r < 16; ++r) acc[a][b][c][r] = 0.f;
    for (int kt = 0; kt < KT; ++kt) {
      __syncthreads();
      *(u32x4*)(As + (lr) * 72 + lc) = ra0; *(u32x4*)(As + (32 + lr) * 72 + lc) = ra1;
      *(u32x4*)(As + (64 + lr) * 72 + lc) = ra2; *(u32x4*)(As + (96 + lr) * 72 + lc) = ra3;
      *(u32x4*)(Bs + (lr) * 72 + lc) = rb0; *(u32x4*)(Bs + (32 + lr) * 72 + lc) = rb1;
      *(u32x4*)(Bs + (64 + lr) * 72 + lc) = rb2; *(u32x4*)(Bs + (96 + lr) * 72 + lc) = rb3;
      *(u32x4*)(Bs + (128 + lr) * 72 + lc) = rb4; *(u32x4*)(Bs + (160 + lr) * 72 + lc) = rb5;
      *(u32x4*)(Bs + (192 + lr) * 72 + lc) = rb6; *(u32x4*)(Bs + (224 + lr) * 72 + lc) = rb7;
      __syncthreads();
      if (kt + 1 < KT) { const int ko = (kt + 1) * 64; GLOAD(ko) }
#pragma unroll
      for (int s = 0; s < 4; ++s) {
        bf16x8 af[2];
#pragma unroll
        for (int mi = 0; mi < 2; ++mi) af[mi] = *(const bf16x8*)(As + (wm * 64 + mi * 32 + i) * 72 + s * 16 + h * 8);
#pragma unroll
        for (int hf = 0; hf < 2; ++hf) {
          bf16x8 bfr[2];
#pragma unroll
          for (int ni = 0; ni < 2; ++ni) bfr[ni] = *(const bf16x8*)(Bs + (wn * 128 + hf * 64 + ni * 32 + i) * 72 + s * 16 + h * 8);
#pragma unroll
          for (int ni = 0; ni < 2; ++ni)
#pragma unroll
            for (int mi = 0; mi < 2; ++mi) acc[hf][mi][ni] = MFMA(bfr[ni], af[mi], acc[hf][mi][ni]);
        }
      }
    }
#undef GLOAD
    __syncthreads();
    epi(acc[0], tm * 128 + wm * 64, tn * 256 + wn * 128, lane, smem + w * 9216);
    epi(acc[1], tm * 128 + wm * 64, tn * 256 + wn * 128 + 64, lane, smem + w * 9216);
  }
}

DI void stage_flush(const bf16_t* img, bf16_t* dst, int ld, int lane) {
  asm volatile("" ::: "memory");
  const bf16_t* ip = img + (lane >> 3) * 72 + (lane & 7) * 8;
  bf16_t* dp = dst + (size_t)(lane >> 3) * ld + (lane & 7) * 8;
#pragma unroll
  for (int ps = 0; ps < 8; ++ps) {
    const u32x4 q = *(const u32x4*)(ip + ps * 8 * 72);
    *(u32x4*)dp = q;
    dp += 8 * ld;
  }
}
DI void st_rm(const f32x16 (&acc)[2][2], char* wsm, bf16_t* dst, int ld, int lane) {
  bf16_t* img = (bf16_t*)wsm;
  bf16_t* lp = img + (lane & 31) * 72 + 4 * (lane >> 5);
#pragma unroll
  for (int mi = 0; mi < 2; ++mi)
#pragma unroll
    for (int ni = 0; ni < 2; ++ni)
#pragma unroll
      for (int a = 0; a < 4; ++a) {
        uint2 o; o.x = pk2(acc[mi][ni][4 * a], acc[mi][ni][4 * a + 1]); o.y = pk2(acc[mi][ni][4 * a + 2], acc[mi][ni][4 * a + 3]);
        *(uint2*)(lp + (32 * mi * 72 + 32 * ni + 8 * a)) = o;
      }
  stage_flush(img, dst, ld, lane);
}
DI void st_rm_rope(const f32x16 (&acc)[2][2], char* wsm, bf16_t* dst, int ld, int lane, const float* cosT, const float* sinT, int pos0) {
  bf16_t* img = (bf16_t*)wsm;
  const int t = lane & 31, h = lane >> 5;
  bf16_t* lp = img + t * 72 + 4 * h;
  const float* cp = cosT + (pos0 + t) * 32 + 4 * h;
  const float* sp = sinT + (pos0 + t) * 32 + 4 * h;
#pragma unroll
  for (int mi = 0; mi < 2; ++mi)
#pragma unroll
    for (int a = 0; a < 4; ++a) {
      const float4 cs = *(const float4*)(cp + (32 * mi * 32 + 8 * a));
      const float4 sn = *(const float4*)(sp + (32 * mi * 32 + 8 * a));
      const float x10 = acc[mi][0][4 * a], x11 = acc[mi][0][4 * a + 1], x12 = acc[mi][0][4 * a + 2], x13 = acc[mi][0][4 * a + 3];
      const float x20 = acc[mi][1][4 * a], x21 = acc[mi][1][4 * a + 1], x22 = acc[mi][1][4 * a + 2], x23 = acc[mi][1][4 * a + 3];
      uint2 o1, o2;
      o1.x = pk2(x10 * cs.x - x20 * sn.x, x11 * cs.y - x21 * sn.y); o1.y = pk2(x12 * cs.z - x22 * sn.z, x13 * cs.w - x23 * sn.w);
      o2.x = pk2(x20 * cs.x + x10 * sn.x, x21 * cs.y + x11 * sn.y); o2.y = pk2(x22 * cs.z + x12 * sn.z, x23 * cs.w + x13 * sn.w);
      *(uint2*)(lp + (32 * mi * 72 + 8 * a)) = o1;
      *(uint2*)(lp + (32 * mi * 72 + 32 + 8 * a)) = o2;
    }
  stage_flush(img, dst, ld, lane);
}
DI void st_tr(const f32x16 (&acc)[2][2], char* wsm, bf16_t* dst, int ld, int lane, int ztok) {
  bf16_t* img = (bf16_t*)wsm;
  const int t = lane & 31, h = lane >> 5;
  bf16_t* lp = img + 4 * h * 72 + t;
#pragma unroll
  for (int mi = 0; mi < 2; ++mi) {
    const bool z = (32 * mi + t) == ztok;
#pragma unroll
    for (int ni = 0; ni < 2; ++ni)
#pragma unroll
      for (int r = 0; r < 16; ++r) {
        const float v = z ? 0.f : acc[mi][ni][r];
        lp[(32 * ni + (r & 3) + 8 * (r >> 2)) * 72 + 32 * mi] = (bf16_t)f2bf(v);
      }
  }
  stage_flush(img, dst, ld, lane);
}

DI f32x16 qk_scores(const bf16x8 (&qf)[4], const bf16_t* __restrict__ Kp, int kstride, int key0, int lane) {
  const int i = lane & 31, h = lane >> 5;
  const int a = i >> 3, hh = (i >> 2) & 1, b = i & 3;
  const int kperm = 16 * (a >> 1) + 8 * hh + 4 * (a & 1) + b;
  const bf16_t* kr = Kp + (size_t)(key0 + kperm) * kstride + 32 * h;
  bf16x8 kf[4];
#pragma unroll
  for (int s = 0; s < 4; ++s) kf[s] = *(const bf16x8*)(kr + 8 * s);
  f32x16 sa;
#pragma unroll
  for (int r = 0; r < 16; ++r) sa[r] = 0.f;
#pragma unroll
  for (int s = 0; s < 4; ++s) sa = MFMA(kf[s], qf[s], sa);
  return sa;
}
DI void load_kf(bf16x8 (&kf)[4], const bf16_t* __restrict__ Kp, int kstride, int key0, int lane) {
  const int i = lane & 31, h = lane >> 5;
  const int a = i >> 3, hh = (i >> 2) & 1, b = i & 3;
  const int kperm = 16 * (a >> 1) + 8 * hh + 4 * (a & 1) + b;
  const bf16_t* kr = Kp + (size_t)(key0 + kperm) * kstride + 32 * h;
#pragma unroll
  for (int s = 0; s < 4; ++s) kf[s] = *(const bf16x8*)(kr + 8 * s);
}
DI f32x16 qk_mfma(const bf16x8 (&kf)[4], const bf16x8 (&qf)[4]) {
  f32x16 sa;
#pragma unroll
  for (int r = 0; r < 16; ++r) sa[r] = 0.f;
#pragma unroll
  for (int s = 0; s < 4; ++s) sa = MFMA(kf[s], qf[s], sa);
  return sa;
}
DI void load_v(bf16x8 (&vf)[2][2], const bf16_t* __restrict__ Vp, int vstride, int key0, int lane) {
  const int i = lane & 31, h = lane >> 5;
#pragma unroll
  for (int dt = 0; dt < 2; ++dt)
#pragma unroll
    for (int s2 = 0; s2 < 2; ++s2) vf[dt][s2] = *(const bf16x8*)(Vp + (size_t)(32 * dt + i) * vstride + key0 + 16 * s2 + 8 * h);
}
DI void pack_p(const float (&p)[16], bf16x8 (&pf)[2]) {
#pragma unroll
  for (int s2 = 0; s2 < 2; ++s2) {
    union { bf16x8 v; unsigned u[4]; } t;
#pragma unroll
    for (int j = 0; j < 4; ++j) t.u[j] = pk2(p[8 * s2 + 2 * j], p[8 * s2 + 2 * j + 1]);
    pf[s2] = t.v;
  }
}
struct Att { float m, l; f32x16 o0, o1; };
DI void att_init(Att& st, float m0, float l0) {
  st.m = m0; st.l = l0;
#pragma unroll
  for (int r = 0; r < 16; ++r) { st.o0[r] = 0.f; st.o1[r] = 0.f; }
}
template <class MaskF>
DI void att_tile(Att& st, const bf16x8 (&qf)[4], const bf16_t* __restrict__ Kp, int kstride, const bf16_t* __restrict__ Vp, int vstride,
                 int key0, int lane, MaskF mask) {
  const int h = lane >> 5;
  f32x16 sa = qk_scores(qf, Kp, kstride, key0, lane);
  bf16x8 vf[2][2];
  load_v(vf, Vp, vstride, key0, lane);
  float p[16];
  float mx = NEG_INF;
#pragma unroll
  for (int r = 0; r < 16; ++r) {
    const int key = key0 + 16 * (r >> 3) + 8 * h + (r & 7);
    const float v = mask(key) ? sa[r] * SC2 : NEG_INF;
    p[r] = v; mx = fmaxf(mx, v);
  }
  mx = fmaxf(mx, __shfl_xor(mx, 32));
  const float mnew = fmaxf(st.m, mx);
  const float msafe = (mnew == NEG_INF) ? 0.f : mnew;
  const float alpha = ex2(st.m - msafe);
  float sum = 0.f;
#pragma unroll
  for (int r = 0; r < 16; ++r) { const float e = ex2(p[r] - msafe); p[r] = e; sum += e; }
  st.l = st.l * alpha + sum; st.m = mnew;
#pragma unroll
  for (int r = 0; r < 16; ++r) { st.o0[r] *= alpha; st.o1[r] *= alpha; }
  bf16x8 pf[2];
  pack_p(p, pf);
#pragma unroll
  for (int s2 = 0; s2 < 2; ++s2) { st.o0 = MFMA(vf[0][s2], pf[s2], st.o0); st.o1 = MFMA(vf[1][s2], pf[s2], st.o1); }
}
DI float att_invl(const Att& st) { const float l = st.l + __shfl_xor(st.l, 32); return l > 0.f ? 1.f / l : 0.f; }
DI void store_out(const f32x16& o0, const f32x16& o1, const bf16_t* __restrict__ zrow, bf16_t* __restrict__ orow, int h) {
  uint2 zz[8];
#pragma unroll
  for (int k = 0; k < 8; ++k) zz[k] = *(const uint2*)(zrow + 32 * (k >> 2) + 8 * (k & 3) + 4 * h);
#pragma unroll
  for (int dt = 0; dt < 2; ++dt)
#pragma unroll
    for (int a = 0; a < 4; ++a) {
      const int d = 32 * dt + 8 * a + 4 * h;
      const uint2 z2 = zz[dt * 4 + a];
      const f32x16& o = dt ? o1 : o0;
      const float r0 = o[4 * a] * siluf(bflo(z2.x)), r1 = o[4 * a + 1] * siluf(bfhi(z2.x));
      const float r2 = o[4 * a + 2] * siluf(bflo(z2.y)), r3 = o[4 * a + 3] * siluf(bfhi(z2.y));
      uint2 ov; ov.x = pk2(r0, r1); ov.y = pk2(r2, r3);
      *(uint2*)(orow + d) = ov;
    }
}

struct TrTile { const float* src; bf16_t* dst; int ldn, src_col0, nvalid, k0, ldk, n0; };
DI void transpose_pair(char* smem, const TrTile& a, const TrTile& b, bool two) {
  float* ta = (float*)smem;
  float* tb = ta + 64 * 65 + 16;
  const int tid = tidx();
  const int kr0 = tid >> 4, c4 = (tid & 15) * 4;
  float4 va[4], vb4[4];
#pragma unroll
  for (int p = 0; p < 4; ++p) {
    va[p] = make_float4(0.f, 0.f, 0.f, 0.f); vb4[p] = make_float4(0.f, 0.f, 0.f, 0.f);
    if (c4 < a.nvalid) va[p] = *(const float4*)(a.src + (size_t)(a.k0 + kr0 + 16 * p) * a.ldn + a.src_col0 + c4);
    if (two && c4 < b.nvalid) vb4[p] = *(const float4*)(b.src + (size_t)(b.k0 + kr0 + 16 * p) * b.ldn + b.src_col0 + c4);
  }
  __syncthreads();
#pragma unroll
  for (int p = 0; p < 4; ++p) {
    const int kr = kr0 + 16 * p;
    ta[kr * 65 + c4] = va[p].x; ta[kr * 65 + c4 + 1] = va[p].y; ta[kr * 65 + c4 + 2] = va[p].z; ta[kr * 65 + c4 + 3] = va[p].w;
    tb[kr * 65 + c4] = vb4[p].x; tb[kr * 65 + c4 + 1] = vb4[p].y; tb[kr * 65 + c4 + 2] = vb4[p].z; tb[kr * 65 + c4 + 3] = vb4[p].w;
  }
  __syncthreads();
  const int n = tid >> 2, ks = (tid & 3) * 16;
  {
    unsigned o[8];
#pragma unroll
    for (int j = 0; j < 8; ++j) o[j] = pk2(ta[(ks + 2 * j) * 65 + n], ta[(ks + 2 * j + 1) * 65 + n]);
    uint4* dp = (uint4*)(a.dst + (size_t)(a.n0 + n) * a.ldk + a.k0 + ks);
    dp[0] = make_uint4(o[0], o[1], o[2], o[3]);
    dp[1] = make_uint4(o[4], o[5], o[6], o[7]);
  }
  if (two) {
    unsigned o[8];
#pragma unroll
    for (int j = 0; j < 8; ++j) o[j] = pk2(tb[(ks + 2 * j) * 65 + n], tb[(ks + 2 * j + 1) * 65 + n]);
    uint4* dp = (uint4*)(b.dst + (size_t)(b.n0 + n) * b.ldk + b.k0 + ks);
    dp[0] = make_uint4(o[0], o[1], o[2], o[3]);
    dp[1] = make_uint4(o[4], o[5], o[6], o[7]);
  }
}
DI TrTile tr_tile(const Params& p, int t) {
  constexpr int T1 = 2 * 48 * 16, T2 = 2 * 64 * 16, T3 = 2 * 16 * 16, T4 = 2 * 16 * 16, T5 = 4 * 4 * 32;
  TrTile r;
  if (t < T1) {
    const int layer = t / 768, q = t % 768, nt = q >> 4, kt = q & 15;
    int src0, nvalid = 64;
    if (nt < 38) src0 = nt * 64; else if (nt < 46) src0 = 2456 + (nt - 38) * 64; else if (nt == 46) { src0 = 2432; nvalid = 24; } else { src0 = 0; nvalid = 0; }
    r.src = p.w_in_even + (size_t)layer * 1024 * 2968; r.ldn = 2968; r.src_col0 = src0; r.nvalid = nvalid; r.k0 = kt * 64;
    r.dst = (bf16_t*)(p.ws + OFF_WIE) + (size_t)layer * 3072 * 1024; r.ldk = 1024; r.n0 = nt * 64;
  } else if ((t -= T1) < T2) {
    const int layer = t / 1024, q = t % 1024, nt = q >> 4, kt = q & 15;
    r.src = p.w_in_odd + (size_t)layer * 1024 * 4096; r.ldn = 4096; r.src_col0 = nt * 64; r.nvalid = 64; r.k0 = kt * 64;
    r.dst = (bf16_t*)(p.ws + OFF_WIO) + (size_t)layer * 4096 * 1024; r.ldk = 1024; r.n0 = nt * 64;
  } else if ((t -= T2) < T3) {
    const int layer = t / 256, q = t % 256, nt = q >> 4, kt = q & 15;
    r.src = p.w_out_even + (size_t)layer * 1024 * 1024; r.ldn = 1024; r.src_col0 = nt * 64; r.nvalid = 64; r.k0 = kt * 64;
    r.dst = (bf16_t*)(p.ws + OFF_WOE) + (size_t)layer * 1024 * 1024; r.ldk = 1024; r.n0 = nt * 64;
  } else if ((t -= T3) < T4) {
    const int layer = t / 256, q = t % 256, nt = q >> 4, kt = q & 15;
    r.src = p.w_out_odd + (size_t)layer * 1024 * 1024; r.ldn = 1024; r.src_col0 = nt * 64; r.nvalid = 64; r.k0 = kt * 64;
    r.dst = (bf16_t*)(p.ws + OFF_WOO) + (size_t)layer * 1024 * 1024; r.ldk = 1024; r.n0 = nt * 64;
  } else if ((t -= T4) < T5) {
    const int lk = t / 128, q = t % 128, nt = q >> 5, kt = q & 31, layer = lk >> 1, kv = lk & 1;
    r.src = (kv ? p.w1v : p.w1k) + (size_t)layer * 2048 * 256; r.ldn = 256; r.src_col0 = nt * 64; r.nvalid = 64; r.k0 = kt * 64;
    r.dst = (bf16_t*)(p.ws + OFF_W1) + (size_t)lk * 256 * 2048; r.ldk = 2048; r.n0 = nt * 64;
  } else {
    t -= T5;
    const int lk = t / 16, q = t % 16, nt = q >> 2, kt = q & 3, layer = lk >> 1, kv = lk & 1;
    r.src = (kv ? p.w2v : p.w2k) + (size_t)layer * 256 * 64; r.ldn = 64; r.src_col0 = 0; r.nvalid = nt ? 0 : 64; r.k0 = kt * 64;
    r.dst = (bf16_t*)(p.ws + OFF_W2) + (size_t)lk * 256 * 256; r.ldk = 256; r.n0 = nt * 64;
  }
  return r;
}

DI void phase_p0(const Params& p, char* smem, int vb, int nb) {
  const int tid = tidx(), lane = tid & 63, w = tid >> 6;
  constexpr int N_ADA = 192, N_PEB = 64, N_ROPE = 256;
  constexpr int U0 = N_ADA + N_PEB + N_ROPE;
  constexpr int T1 = 2 * 48 * 16, T2 = 2 * 64 * 16, T3 = 2 * 16 * 16, T4 = 2 * 16 * 16, T5 = 4 * 4 * 32, T6 = 4 * 4 * 4;
  constexpr int NU = U0 + T1 + T2 + T3 + T4 + T5 + T6;
  for (int k = vb * 256 + tid; k < 4 * T_; k += nb * 256) ((float*)(p.ws + OFF_ROWSS))[T_ + k] = 0.f;
  for (int k = vb * 256 + tid; k < 2 * 65536; k += nb * 256) ((float*)(p.ws + OFF_KMEAN))[k] = 0.f;
  for (int u = vb; u < NU; u += nb) {
    if (u < N_ADA) {
      float* sc = (float*)smem;
      __syncthreads();
      for (int k = tid; k < 8192; k += 256) sc[k] = siluf(p.c[k]);
      __syncthreads();
      const int l = u / 48, eg = u % 48, e = eg * 64 + lane;
      float acc[8];
#pragma unroll
      for (int b = 0; b < 8; ++b) acc[b] = 0.f;
      const float* wp = p.w_ada + (size_t)l * 1024 * 3072 + e;
#pragma unroll 8
      for (int d0 = w * 256; d0 < w * 256 + 256; d0 += 4) {
        const float w0 = wp[(size_t)d0 * 3072], w1 = wp[(size_t)(d0 + 1) * 3072], w2 = wp[(size_t)(d0 + 2) * 3072], w3 = wp[(size_t)(d0 + 3) * 3072];
#pragma unroll
        for (int b = 0; b < 8; ++b) {
          const float4 cv = *(const float4*)(sc + b * 1024 + d0);
          acc[b] += cv.x * w0 + cv.y * w1 + cv.z * w2 + cv.w * w3;
        }
      }
      __syncthreads();
      float* red = (float*)smem;
#pragma unroll
      for (int b = 0; b < 8; ++b) red[(w * 8 + b) * 64 + lane] = acc[b];
      __syncthreads();
      for (int k = tid; k < 512; k += 256) {
        const int b = k >> 6, ln = k & 63;
        const float v = red[(0 * 8 + b) * 64 + ln] + red[(1 * 8 + b) * 64 + ln] + red[(2 * 8 + b) * 64 + ln] + red[(3 * 8 + b) * 64 + ln];
        const int ee = eg * 64 + ln;
        ((float*)(p.ws + OFF_ADA))[(size_t)(l * 8 + b) * 3072 + ee] = v + p.b_ada[l * 3072 + ee];
      }
    } else if (u < N_ADA + N_PEB) {
      const int uu = u - N_ADA, lk = uu >> 4, ch = uu & 15, layer = lk >> 1, kv = lk & 1;
      const float* pe = (kv ? p.pe_v : p.pe_k) + layer * 2048;
      const float* w1 = (kv ? p.w1v : p.w1k) + (size_t)layer * 2048 * 256;
      float acc = 0.f;
#pragma unroll 16
      for (int k = ch * 128; k < ch * 128 + 128; ++k) acc += pe[k] * w1[(size_t)k * 256 + tid];
      ((float*)(p.ws + OFF_PEB))[(lk * 16 + ch) * 256 + tid] = acc;
    } else if (u < U0) {
      const int idx = (u - N_ADA - N_PEB) * 256 + tid, pos = idx >> 5, j = idx & 31;
      const float inv = powf(10000.f, -(float)(2 * j) / 64.f);
      const float ang = (float)pos * inv;
      ((float*)(p.ws + OFF_ROPE))[idx] = cosf(ang);
      ((float*)(p.ws + OFF_ROPE))[65536 + idx] = sinf(ang);
    } else {
      const int u2 = u + nb;
      const bool two = u2 < NU;
      const TrTile ta = tr_tile(p, u - U0);
      const TrTile tb = tr_tile(p, (two ? u2 : u) - U0);
      transpose_pair(smem, ta, tb, two);
      u += nb;
    }
  }
}

DI float wave_sum(float v) {
#pragma unroll
  for (int o = 32; o > 0; o >>= 1) v += __shfl_xor(v, o);
  return v;
}
DI void phase_prep0(const Params& p, char* smem, int vb, int nb) {
  const int tid = tidx(), lane = tid & 63, w = tid >> 6;
  const float* ada = (const float*)(p.ws + OFF_ADA);
  for (int u = vb; u < 448; u += nb) {
    int l, cg;
    if (u < 96) { l = 0; cg = u; } else if (u < 224) { l = 1; cg = u - 96; } else if (u < 320) { l = 2; cg = u - 224; } else { l = 3; cg = u - 320; }
    const bf16_t* Wt = (l & 1) ? (const bf16_t*)(p.ws + OFF_WIO) + (size_t)(l >> 1) * 4096 * 1024 : (const bf16_t*)(p.ws + OFF_WIE) + (size_t)(l >> 1) * 3072 * 1024;
    float* sh = (float*)smem;
    __syncthreads();
    for (int k = tid; k < 8192; k += 256) sh[k] = ada[(size_t)(l * 8 + (k >> 10)) * 3072 + (k & 1023)];
    __syncthreads();
    float* bias = (float*)(p.ws + OFF_BIAS) + (size_t)l * 8 * 4096;
    for (int j = 0; j < 8; ++j) {
      const int n = cg * 32 + w * 8 + j;
      const u32x4 q0 = *(const u32x4*)(Wt + (size_t)n * 1024 + lane * 16), q1 = *(const u32x4*)(Wt + (size_t)n * 1024 + lane * 16 + 8);
      float wv[16];
#pragma unroll
      for (int e = 0; e < 4; ++e) { wv[2 * e] = bflo(q0[e]); wv[2 * e + 1] = bfhi(q0[e]); wv[8 + 2 * e] = bflo(q1[e]); wv[8 + 2 * e + 1] = bfhi(q1[e]); }
#pragma unroll
      for (int b = 0; b < 8; ++b) {
        float a = 0.f;
#pragma unroll
        for (int e4 = 0; e4 < 4; ++e4) {
          const f32x4 sv = *(const f32x4*)(sh + b * 1024 + lane * 16 + 4 * e4);
          a += sv[0] * wv[4 * e4] + sv[1] * wv[4 * e4 + 1] + sv[2] * wv[4 * e4 + 2] + sv[3] * wv[4 * e4 + 3];
        }
        a = wave_sum(a);
        if (lane == 0) bias[b * 4096 + n] = a;
      }
    }
  }
  for (int k = vb * 256 + tid; k < 1024; k += nb * 256) {
    const float* pb = (const float*)(p.ws + OFF_PEB) + (k >> 8) * 16 * 256 + (k & 255);
    float a = 0.f;
#pragma unroll
    for (int ch = 0; ch < 16; ++ch) a += pb[ch * 256];
    ((float*)(p.ws + OFF_PEBF))[k] = a;
  }
  for (int k = vb * 256 + tid; k < 4 * 8 * 1024; k += nb * 256) {
    const int l = k >> 13, b = (k >> 10) & 7, c = k & 1023;
    ((float*)(p.ws + OFF_GG))[k] = p.norm_g[l * 1024 + c] * (1.f + ada[(size_t)(l * 8 + b) * 3072 + 1024 + c]);
  }
  bf16_t* A2 = (bf16_t*)(p.ws + OFF_A2);
  float* rowss = (float*)(p.ws + OFF_ROWSS);
  float4 gw[4];
#pragma unroll
  for (int k = 0; k < 4; ++k) gw[k] = *(const float4*)(p.norm_g + k * 256 + lane * 4);
  const int rstep = nb * 4;
  for (int row = vb * 4 + w; row < T_; row += 2 * rstep) {
    const int row1 = row + rstep;
    const bool has1 = row1 < T_;
    const float* xr0 = p.x + (size_t)row * 1024;
    const float* xr1 = p.x + (size_t)(has1 ? row1 : row) * 1024;
    float4 v0[4], v1[4], s0[4], s1[4];
#pragma unroll
    for (int k = 0; k < 4; ++k) { v0[k] = *(const float4*)(xr0 + k * 256 + lane * 4); v1[k] = *(const float4*)(xr1 + k * 256 + lane * 4); }
#pragma unroll
    for (int k = 0; k < 4; ++k) {
      s0[k] = *(const float4*)(ada + (size_t)(row >> 11) * 3072 + 1024 + k * 256 + lane * 4);
      s1[k] = *(const float4*)(ada + (size_t)((has1 ? row1 : row) >> 11) * 3072 + 1024 + k * 256 + lane * 4);
    }
    float ss0 = 0.f, ss1 = 0.f;
#pragma unroll
    for (int k = 0; k < 4; ++k) {
      ss0 += v0[k].x * v0[k].x + v0[k].y * v0[k].y + v0[k].z * v0[k].z + v0[k].w * v0[k].w;
      ss1 += v1[k].x * v1[k].x + v1[k].y * v1[k].y + v1[k].z * v1[k].z + v1[k].w * v1[k].w;
    }
    ss0 = wave_sum(ss0); ss1 = wave_sum(ss1);
    if (lane == 0) { rowss[row] = ss0; if (has1) rowss[row1] = ss1; }
#pragma unroll
    for (int k = 0; k < 4; ++k) {
      const int col = k * 256 + lane * 4;
      const float4 g = gw[k];
      uint2 o;
      o.x = pk2(v0[k].x * g.x * (1.f + s0[k].x), v0[k].y * g.y * (1.f + s0[k].y)); o.y = pk2(v0[k].z * g.z * (1.f + s0[k].z), v0[k].w * g.w * (1.f + s0[k].w));
      *(uint2*)(A2 + (size_t)row * 1024 + col) = o;
      if (has1) {
        o.x = pk2(v1[k].x * g.x * (1.f + s1[k].x), v1[k].y * g.y * (1.f + s1[k].y)); o.y = pk2(v1[k].z * g.z * (1.f + s1[k].z), v1[k].w * g.w * (1.f + s1[k].w));
        *(uint2*)(A2 + (size_t)row1 * 1024 + col) = o;
      }
    }
  }
}
DI void phase_final(const Params& p, int vb, int nb) {
  const int lane = tidx() & 63, w = tidx() >> 6;
  const float* rowss = (const float*)(p.ws + OFF_ROWSS) + 4 * T_;
  float4 gw[4];
#pragma unroll
  for (int k = 0; k < 4; ++k) gw[k] = *(const float4*)(p.final_g + k * 256 + lane * 4);
  const int rstep = nb * 4;
  for (int row = vb * 4 + w; row < T_; row += 2 * rstep) {
    const int row1 = row + rstep;
    const bool has1 = row1 < T_;
    float* xr0 = p.out + (size_t)row * 1024;
    float* xr1 = p.out + (size_t)(has1 ? row1 : row) * 1024;
    float4 v0[4], v1[4];
#pragma unroll
    for (int k = 0; k < 4; ++k) { v0[k] = *(const float4*)(xr0 + k * 256 + lane * 4); v1[k] = *(const float4*)(xr1 + k * 256 + lane * 4); }
    const float rs0 = rsqrtf(rowss[row] * (1.f / 1024.f) + 1e-6f), rs1 = rsqrtf(rowss[has1 ? row1 : row] * (1.f / 1024.f) + 1e-6f);
#pragma unroll
    for (int k = 0; k < 4; ++k) {
      const float4 g = gw[k];
      float4 o; o.x = v0[k].x * rs0 * g.x; o.y = v0[k].y * rs0 * g.y; o.z = v0[k].z * rs0 * g.z; o.w = v0[k].w * rs0 * g.w;
      *(float4*)(xr0 + k * 256 + lane * 4) = o;
    }
    if (has1) {
#pragma unroll
      for (int k = 0; k < 4; ++k) {
        const float4 g = gw[k];
        float4 o; o.x = v1[k].x * rs1 * g.x; o.y = v1[k].y * rs1 * g.y; o.z = v1[k].z * rs1 * g.z; o.w = v1[k].w * rs1 * g.w;
        *(float4*)(xr1 + k * 256 + lane * 4) = o;
      }
    }
  }
}
DI void apply_rs_bias(f32x16 (&acc)[2][2], const float* rowss, const float* bias, int row0, int col0, int lane) {
  const int t = lane & 31, h = lane >> 5;
  const float rs0 = rsqrtf(rowss[row0 + t] * (1.f / 1024.f) + 1e-6f), rs1 = rsqrtf(rowss[row0 + 32 + t] * (1.f / 1024.f) + 1e-6f);
#pragma unroll
  for (int ni = 0; ni < 2; ++ni)
#pragma unroll
    for (int a = 0; a < 4; ++a) {
      const f32x4 bv = *(const f32x4*)(bias + col0 + 32 * ni + 8 * a + 4 * h);
#pragma unroll
      for (int bb = 0; bb < 4; ++bb) {
        acc[0][ni][4 * a + bb] = acc[0][ni][4 * a + bb] * rs0 + bv[bb];
        acc[1][ni][4 * a + bb] = acc[1][ni][4 * a + bb] * rs1 + bv[bb];
      }
    }
}

DI void phase_g1_even(const Params& p, char* smem, int li, int vb, int nb) {
  const bf16_t* H = (const bf16_t*)(p.ws + OFF_A2);
  const float* rowss = (const float*)(p.ws + OFF_ROWSS) + (size_t)(2 * li) * T_;
  const float* biasl = (const float*)(p.ws + OFF_BIAS) + (size_t)(2 * li) * 8 * 4096;
  const bf16_t* Wt = (const bf16_t*)(p.ws + OFF_WIE) + (size_t)li * 3072 * 1024;
  const float* cosT = (const float*)(p.ws + OFF_ROPE);
  const float* sinT = cosT + 65536;
  char* ws = p.ws;
  auto epi = [&](f32x16 (&acc)[2][2], int row0, int col0, int lane, char* wsm) {
    const int ct = col0 >> 6, b = row0 >> 11, s0 = row0 & 2047;
    if (ct >= 47) return;
    apply_rs_bias(acc, rowss, biasl + b * 4096, row0, col0, lane);
    int mode;
    bf16_t* dst; int ld;
    if (ct < 8) { mode = 1; dst = (bf16_t*)(ws + E_QA) + (size_t)row0 * 512 + ct * 64; ld = 512; }
    else if (ct == 8) { mode = 1; dst = (bf16_t*)(ws + E_KA) + (size_t)row0 * 64; ld = 64; }
    else if (ct == 9) { mode = 2; dst = (bf16_t*)(ws + E_VAT) + (size_t)b * 64 * 2048 + s0; ld = 2048; }
    else if (ct < 18) { mode = 0; dst = (bf16_t*)(ws + E_ZA) + (size_t)row0 * 512 + (ct - 10) * 64; ld = 512; }
    else if (ct < 26) { mode = 1; dst = (bf16_t*)(ws + E_QB) + (size_t)row0 * 512 + (ct - 18) * 64; ld = 512; }
    else if (ct < 28) { mode = 1; dst = (bf16_t*)(ws + E_KC) + ((size_t)(b * 2 + ct - 26) * 2048 + s0) * 64; ld = 64; }
    else if (ct < 30) { mode = 0; dst = (bf16_t*)(ws + E_VC) + ((size_t)(b * 2 + ct - 28) * 2048 + s0) * 64; ld = 64; }
    else if (ct < 32) { mode = 1; dst = (bf16_t*)(ws + E_KS) + (size_t)row0 * 128 + (ct - 30) * 64; ld = 128; }
    else if (ct < 34) { mode = 2; dst = (bf16_t*)(ws + E_VST) + (size_t)(b * 2 + ct - 32) * 64 * 2048 + s0; ld = 2048; }
    else if (ct < 36) { mode = 1; dst = (bf16_t*)(ws + E_KW) + (size_t)row0 * 128 + (ct - 34) * 64; ld = 128; }
    else if (ct < 38) { mode = 2; dst = (bf16_t*)(ws + E_VWT) + (size_t)(b * 2 + ct - 36) * 64 * 2048 + s0; ld = 2048; }
    else if (ct < 46) { mode = 0; dst = (bf16_t*)(ws + E_ZB) + (size_t)row0 * 512 + (ct - 38) * 64; ld = 512; }
    else if (ct == 46) { mode = 3; dst = nullptr; ld = 0; }
    else { mode = 4; dst = nullptr; ld = 0; }
    if (mode == 0) st_rm(acc, wsm, dst, ld, lane);
    else if (mode == 1) st_rm_rope(acc, wsm, dst, ld, lane, cosT, sinT, s0);
    else if (mode == 2) st_tr(acc, wsm, dst, ld, lane, -1);
    else if (mode == 3) {
      float* GB = (float*)(ws + E_GB);
      const int t = lane & 31, h = lane >> 5;
#pragma unroll
      for (int mi = 0; mi < 2; ++mi)
#pragma unroll
        for (int a = 0; a < 3; ++a) {
          float4 o; o.x = acc[mi][0][4 * a]; o.y = acc[mi][0][4 * a + 1]; o.z = acc[mi][0][4 * a + 2]; o.w = acc[mi][0][4 * a + 3];
          *(float4*)(GB + (size_t)(row0 + 32 * mi + t) * 24 + 8 * a + 4 * h) = o;
        }
    }
  };
  gemm_tiles(smem, H, [](int r) { return (size_t)r * 1024; }, Wt, 1024, 1024, 128, 12, vb, nb, epi, true);
}
DI void phase_g1_odd(const Params& p, char* smem, int li, int vb, int nb) {
  const bf16_t* H = (const bf16_t*)(p.ws + OFF_A2);
  float* kmean = (float*)(p.ws + OFF_KMEAN) + (size_t)li * 65536;
  const float* rowss = (const float*)(p.ws + OFF_ROWSS) + (size_t)(2 * li + 1) * T_;
  const float* biasl = (const float*)(p.ws + OFF_BIAS) + (size_t)(2 * li + 1) * 8 * 4096;
  const bf16_t* Wt = (const bf16_t*)(p.ws + OFF_WIO) + (size_t)li * 4096 * 1024;
  const float* cosT = (const float*)(p.ws + OFF_ROPE);
  const float* sinT = cosT + 65536;
  char* ws = p.ws;
  auto epi = [&](f32x16 (&acc)[2][2], int row0, int col0, int lane, char* wsm) {
    const int ct = col0 >> 6, b = row0 >> 11, s0 = row0 & 2047;
    apply_rs_bias(acc, rowss, biasl + b * 4096, row0, col0, lane);
    if (ct < 32) {
      st_rm_rope(acc, wsm, (bf16_t*)(ws + (ct < 16 ? O_Q : O_K)) + (size_t)row0 * 1024 + (ct & 15) * 64, 1024, lane, cosT, sinT, s0);
      if (ct >= 16) {
        const bf16_t* img = (const bf16_t*)wsm + lane;
        float cs = 0.f;
#pragma unroll 16
        for (int r = 0; r < 64; ++r) cs += bf2f(img[r * 72]);
        atomicAdd(kmean + (((size_t)b * 16 + (ct - 16)) * 8 + (s0 >> 8)) * 64 + lane, cs * (1.f / 256.f));
      }
    }
    else if (ct < 48) st_tr(acc, wsm, (bf16_t*)(ws + O_VT) + (size_t)(b * 16 + ct - 32) * 64 * 2048 + s0, 2048, lane, -1);
    else st_rm(acc, wsm, (bf16_t*)(ws + O_Z) + (size_t)row0 * 1024 + (ct - 48) * 64, 1024, lane);
  };
  gemm_tiles(smem, H, [](int r) { return (size_t)r * 1024; }, Wt, 1024, 1024, 128, 16, vb, nb, epi, true);
}
DI void phase_out(const Params& p, char* smem, int layer, int vb, int nb) {
  const bf16_t* AO = (const bf16_t*)(p.ws + OFF_H);
  const bf16_t* Wt = (const bf16_t*)(p.ws + ((layer & 1) ? OFF_WOO : OFF_WOE)) + (size_t)(layer >> 1) * 1024 * 1024;
  const float* xin = layer == 0 ? p.x : p.out;
  float* xo = p.out;
  const float* ada = (const float*)(p.ws + OFF_ADA);
  bf16_t* A2 = (bf16_t*)(p.ws + OFF_A2);
  float* rowss = (float*)(p.ws + OFF_ROWSS) + (size_t)(layer + 1) * T_;
  const float* ggn = (const float*)(p.ws + OFF_GG) + (size_t)(layer < 3 ? layer + 1 : 3) * 8 * 1024;
  auto epi = [&](const f32x16 (&acc)[2][2], int row0, int col0, int lane, char* wsm) {
    const int t = lane & 31, h = lane >> 5, b = row0 >> 11;
    float* img = (float*)wsm;
    const int rr = lane >> 4, cc = (lane & 15) * 4;
    const f32x4 gate = *(const f32x4*)(ada + (size_t)(layer * 8 + b) * 3072 + 2048 + col0 + cc);
    const f32x4 gg = *(const f32x4*)(ggn + b * 1024 + col0 + cc);
#pragma unroll
    for (int mi = 0; mi < 2; ++mi) {
#pragma unroll
      for (int ni = 0; ni < 2; ++ni)
#pragma unroll
        for (int a = 0; a < 4; ++a) {
          f32x4 o; o[0] = acc[mi][ni][4 * a]; o[1] = acc[mi][ni][4 * a + 1]; o[2] = acc[mi][ni][4 * a + 2]; o[3] = acc[mi][ni][4 * a + 3];
          *(f32x4*)(img + t * 68 + 32 * ni + 8 * a + 4 * h) = o;
        }
      asm volatile("" ::: "memory");
      f32x4 xv[8];
#pragma unroll
      for (int ps = 0; ps < 8; ++ps) xv[ps] = __builtin_nontemporal_load((const f32x4*)(xin + (size_t)(row0 + 32 * mi + ps * 4 + rr) * 1024 + col0 + cc));
#pragma unroll
      for (int ps = 0; ps < 8; ++ps) {
        const int row = ps * 4 + rr;
        const f32x4 y = *(const f32x4*)(img + row * 68 + cc);
        const size_t o = (size_t)(row0 + 32 * mi + row) * 1024 + col0 + cc;
        const f32x4 xn = xv[ps] + gate * y;
        *(f32x4*)(xo + o) = xn;
        if (layer < 3) { uint2 a2; a2.x = pk2(xn[0] * gg[0], xn[1] * gg[1]); a2.y = pk2(xn[2] * gg[2], xn[3] * gg[3]); *(uint2*)(A2 + o) = a2; }
        float sq = xn[0] * xn[0] + xn[1] * xn[1] + xn[2] * xn[2] + xn[3] * xn[3];
        sq += __shfl_xor(sq, 1); sq += __shfl_xor(sq, 2); sq += __shfl_xor(sq, 4); sq += __shfl_xor(sq, 8);
        if ((lane & 15) == 0) atomicAdd(rowss + row0 + 32 * mi + row, sq);
      }
      asm volatile("" ::: "memory");
    }
  };
  gemm_tiles(smem, AO, [](int r) { return (size_t)r * 1024; }, Wt, 1024, 1024, 128, 4, vb, nb, epi, true);
}

DI void mlp1_tile(const Params& p, char* smem, int li, int t) {
  const int ks = t & 3, kv = t >> 6, tt = (t >> 2) & 15, lk = li * 2 + kv;
  const bf16_t* A = (const bf16_t*)(p.ws + (kv ? E_VC : E_KC)) + ks * 512;
  const bf16_t* Wt = (const bf16_t*)(p.ws + OFF_W1) + (size_t)lk * 256 * 2048 + ks * 512;
  float* part = (float*)(p.ws + OFF_PART) + (size_t)(ks * 2 + kv) * 2048 * 256;
  auto epi = [&](const f32x16 (&acc)[2][2], int row0, int col0, int lane, char* wsm) {
    const int t2 = lane & 31, h = lane >> 5;
#pragma unroll
    for (int mi = 0; mi < 2; ++mi)
#pragma unroll
      for (int ni = 0; ni < 2; ++ni)
#pragma unroll
        for (int a = 0; a < 4; ++a) {
          f32x4 o; o[0] = acc[mi][ni][4 * a]; o[1] = acc[mi][ni][4 * a + 1]; o[2] = acc[mi][ni][4 * a + 2]; o[3] = acc[mi][ni][4 * a + 3];
          *(f32x4*)(part + (size_t)(row0 + 32 * mi + t2) * 256 + col0 + 32 * ni + 8 * a + 4 * h) = o;
        }
  };
  gemm_tiles(smem, A, [](int r) { return (size_t)(r >> 7) * 131072 + (size_t)(r & 127) * 1024; }, Wt, 2048, 512, 16, 1, tt, 1 << 30, epi);
}
DI void hid_rows(const Params& p, int li, int kv, int row_base) {
  const float* part = (const float*)(p.ws + OFF_PART);
  bf16_t* Hd = (bf16_t*)(p.ws + OFF_HID);
  const int base_idx = (kv * 2048 + row_base) * 64;
  constexpr size_t PSTR = (size_t)2 * 2048 * 256;
  const float* pebf = (const float*)(p.ws + OFF_PEBF) + (li * 2 + kv) * 256;
  for (int j0 = tidx(); j0 < 128 * 64; j0 += 4 * 256) {
    f32x4 pv[4][5];
#pragma unroll
    for (int q = 0; q < 4; ++q) {
      const int idx = base_idx + j0 + q * 256;
      const size_t e = (size_t)idx * 4;
#pragma unroll
      for (int k = 0; k < 4; ++k) pv[q][k] = *(const f32x4*)(part + k * PSTR + e);
      pv[q][4] = *(const f32x4*)(pebf + (idx & 63) * 4);
    }
#pragma unroll
    for (int q = 0; q < 4; ++q) {
      const int idx = base_idx + j0 + q * 256;
      const size_t e = (size_t)idx * 4;
      const f32x4 v = (pv[q][0] + pv[q][1]) + (pv[q][2] + pv[q][3]) + pv[q][4];
      float g[4];
#pragma unroll
      for (int bb = 0; bb < 4; ++bb) {
        const float xv = v[bb];
        const float uu = 0.7978845608028654f * (xv + 0.044715f * xv * xv * xv);
        const float th = 1.f - 2.f / (__expf(2.f * uu) + 1.f);
        g[bb] = 0.5f * xv * (1.f + th);
      }
      uint2 o; o.x = pk2(g[0], g[1]); o.y = pk2(g[2], g[3]);
      *(uint2*)(Hd + e) = o;
    }
  }
  asm volatile("s_waitcnt vmcnt(0)" ::: "memory");
  __syncthreads();
}
DI void mlp2_tile(const Params& p, char* smem, int li, int t) {
  const int kv = t >> 4, tt = t & 15, lk = li * 2 + kv;
  hid_rows(p, li, kv, tt * 128);
  const bf16_t* A = (const bf16_t*)(p.ws + OFF_HID) + (size_t)kv * 2048 * 256;
  const bf16_t* Wt = (const bf16_t*)(p.ws + OFF_W2) + (size_t)lk * 256 * 256;
  bf16_t* KC = (bf16_t*)(p.ws + OFF_KCMP);
  bf16_t* VT = (bf16_t*)(p.ws + OFF_VCMPT);
  auto epi = [&](const f32x16 (&acc)[2][2], int row0, int col0, int lane, char* wsm) {
    if (col0 != 0) return;
    const int bg = row0 >> 7, c0 = row0 & 127;
    if (kv == 0) {
      f32x16 g[2][2];
      const int t = lane & 31;
#pragma unroll
      for (int mi = 0; mi < 2; ++mi)
#pragma unroll
        for (int ni = 0; ni < 2; ++ni)
#pragma unroll
          for (int r = 0; r < 16; ++r) g[mi][ni][r] = (c0 + 32 * mi + t == 127) ? 0.f : acc[mi][ni][r];
      st_rm(g, wsm, KC + (size_t)row0 * 64, 64, lane);
    } else {
      st_tr(acc, wsm, VT + (size_t)bg * 64 * 128 + c0, 128, lane, 127 - c0);
    }
  };
  gemm_tiles(smem, A, [](int r) { return (size_t)r * 256; }, Wt, 256, 256, 16, 1, tt, 1 << 30, epi);
}

constexpr float LAZY = 6.f;
#define TILE_ISSUE(key0_)                                                          \
  do {                                                                             \
    const int kk_ = (key0_);                                                       \
    gk0 = *(const u32x4*)(K + (size_t)(kk_ + ldr) * kstride + ldc);                \
    gk1 = *(const u32x4*)(K + (size_t)(kk_ + ldr + 32) * kstride + ldc);           \
    gv0 = *(const u32x4*)(V + (size_t)(ldr) * vstride + kk_ + ldc);                \
    gv1 = *(const u32x4*)(V + (size_t)(ldr + 32) * vstride + kk_ + ldc);           \
  } while (0)
#define TILE_STORE(Kb_)                                                            \
  do {                                                                             \
    bf16_t* kb_ = (Kb_);                                                           \
    *(u32x4*)(kb_ + ldr * 72 + ldc) = gk0;                                         \
    *(u32x4*)(kb_ + (ldr + 32) * 72 + ldc) = gk1;                                  \
    *(u32x4*)(kb_ + 64 * 72 + ldr * 72 + ldc) = gv0;                               \
    *(u32x4*)(kb_ + 64 * 72 + (ldr + 32) * 72 + ldc) = gv1;                        \
  } while (0)
template <int MODE, class MF>
DI void att_tile64(Att& st, const bf16x8 (&qf)[4], const bf16_t* Kb, const bf16_t* Vb, int lane, const MF& mf) {
  const int i = lane & 31, h = lane >> 5;
  const int a = i >> 3, hh = (i >> 2) & 1, b = i & 3;
  const int kperm = 16 * (a >> 1) + 8 * hh + 4 * (a & 1) + b;
  f32x16 sa[2];
#pragma unroll
  for (int sub = 0; sub < 2; ++sub) {
#pragma unroll
    for (int r = 0; r < 16; ++r) sa[sub][r] = 0.f;
#pragma unroll
    for (int s = 0; s < 4; ++s) {
      const bf16x8 kf = *(const bf16x8*)(Kb + (32 * sub + kperm) * 72 + 32 * h + 8 * s);
      sa[sub] = MFMA(kf, qf[s], sa[sub]);
    }
  }
  float mx = NEG_INF;
#pragma unroll
  for (int sub = 0; sub < 2; ++sub)
#pragma unroll
    for (int r = 0; r < 16; ++r) {
      if (MODE == 2 || MODE == 4) {
        const int c = 32 * sub + 16 * (r >> 3) + (r & 7);
        bool ok = c <= mf.lim_hi;
        if (MODE == 4) ok = ok && (c > mf.lim_lo);
        if (!ok) sa[sub][r] = NEG_INF;
      }
      mx = fmaxf(mx, sa[sub][r]);
    }
  mx = fmaxf(mx, __shfl_xor(mx, 32)) * SC2;
  if (MODE == 3) mx = mf.on ? mx : NEG_INF;
  const bool upd = mx > st.m + LAZY;
  if (__any(upd)) {
    const float mnew = upd ? mx : st.m;
    const float alpha = upd ? ex2(st.m - mnew) : 1.f;
    st.m = mnew; st.l *= alpha;
#pragma unroll
    for (int r = 0; r < 16; ++r) { st.o0[r] *= alpha; st.o1[r] *= alpha; }
  }
  float nm = (st.m == NEG_INF) ? 0.f : -st.m;
  if (MODE == 3) nm = mf.on ? nm : NEG_INF;
  float sum = 0.f;
#pragma unroll
  for (int sub = 0; sub < 2; ++sub)
#pragma unroll
    for (int r = 0; r < 16; ++r) { const float e = ex2(__builtin_fmaf(sa[sub][r], SC2, nm)); sa[sub][r] = e; sum += e; }
  st.l += sum;
#pragma unroll
  for (int sub = 0; sub < 2; ++sub)
#pragma unroll
    for (int s2 = 0; s2 < 2; ++s2) {
      union { bf16x8 v; unsigned u[4]; } t;
#pragma unroll
      for (int j = 0; j < 4; ++j) t.u[j] = pk2(sa[sub][8 * s2 + 2 * j], sa[sub][8 * s2 + 2 * j + 1]);
      const bf16x8 vf0 = *(const bf16x8*)(Vb + (i) * 72 + 32 * sub + 16 * s2 + 8 * h);
      const bf16x8 vf1 = *(const bf16x8*)(Vb + (32 + i) * 72 + 32 * sub + 16 * s2 + 8 * h);
      st.o0 = MFMA(vf0, t.v, st.o0);
      st.o1 = MFMA(vf1, t.v, st.o1);
    }
}
template <class MF>
DI void att_stream(char* smem, Att& st, const bf16x8 (&qf)[4], const bf16_t* __restrict__ K, int kstride, const bf16_t* __restrict__ V, int vstride,
                   int tlo, int thi, int lane, MF& mf) {
  bf16_t* base = (bf16_t*)smem;
  u32x4 gk0, gk1, gv0, gv1;
  const int ldt = tidx(), ldr = ldt >> 3, ldc = (ldt & 7) * 8;
  __syncthreads();
  TILE_ISSUE(tlo * 64);
  TILE_STORE(base);
  TILE_ISSUE(((tlo + 1 <= thi) ? tlo + 1 : tlo) * 64);
  __syncthreads();
  for (int t = tlo; t <= thi; ++t) {
    const int cur = (t - tlo) & 1;
    bf16_t* Kb = base + cur * (2 * 64 * 72);
    bf16_t* Kn = base + (cur ^ 1) * (2 * 64 * 72);
    if (t + 1 <= thi) TILE_STORE(Kn);
    if (t + 2 <= thi) TILE_ISSUE((t + 2) * 64);
    const int c = mf.cls(t * 64);
    if (c == 1) att_tile64<1>(st, qf, Kb, Kb + 64 * 72, lane, mf);
    else if (c == 2) att_tile64<2>(st, qf, Kb, Kb + 64 * 72, lane, mf);
    else if (c == 3) att_tile64<3>(st, qf, Kb, Kb + 64 * 72, lane, mf);
    else if (c == 4) att_tile64<4>(st, qf, Kb, Kb + 64 * 72, lane, mf);
    __syncthreads();
  }
}
struct MaskWin {
  int token, t0, win, h8; int lim_hi, lim_lo; bool on;
  DI int cls(int key0) {
    if (key0 > t0 + 31 || key0 + 63 <= t0 - win) return 0;
    const bool lo_ok = key0 > t0 + 31 - win;
    if (key0 + 63 <= t0 && lo_ok) return 1;
    lim_hi = token - key0 - h8; lim_lo = token - win - key0 - h8;
    return lo_ok ? 2 : 4;
  }
};
struct MaskSel {
  unsigned sel; int token, t0, h8; int lim_hi, lim_lo; bool on;
  DI int cls(int key0) {
    on = (sel >> (key0 >> 6)) & 1u;
    const unsigned long long bal = __ballot(on);
    if (bal == 0ull || key0 > t0 + 31) return 0;
    if (key0 + 63 <= t0) return bal == ~0ull ? 1 : 3;
    lim_hi = on ? token - key0 - h8 : -1;
    return 2;
  }
};
struct MaskMoba {
  unsigned sel; int token, t0, ob, h8; int lim_hi, lim_lo; bool on;
  DI int cls(int key0) {
    if (key0 < ob * 256) {
      on = (sel >> (key0 >> 8)) & 1u;
      const unsigned long long bal = __ballot(on);
      return bal == 0ull ? 0 : (bal == ~0ull ? 1 : 3);
    }
    if (key0 > t0 + 31) return 0;
    if (key0 + 63 <= t0) return 1;
    lim_hi = token - key0 - h8;
    return 2;
  }
};

DI void swa_unit(const Params& p, char* smem, int li, int u) {
  const int lane = tidx() & 63, w = tidx() >> 6, i = lane & 31, h = lane >> 5;
  const int b = u >> 7, tt = (u >> 1) & 63, hg = u & 1, head = hg * 4 + w, t0 = tt * 32, token = t0 + i;
  const size_t grow = (size_t)b * S_ + token;
  const bf16_t* qp = (const bf16_t*)(p.ws + E_QA) + grow * 512 + head * 64 + 32 * h;
  bf16x8 qf[4];
#pragma unroll
  for (int s = 0; s < 4; ++s) qf[s] = *(const bf16x8*)(qp + 8 * s);
  const bf16_t* Kp = (const bf16_t*)(p.ws + E_KA) + (size_t)b * S_ * 64;
  const bf16_t* Vp = (const bf16_t*)(p.ws + E_VAT) + (size_t)b * 64 * S_;
  Att st;
  att_init(st, p.a_sinks[li * 8 + head] * LOG2E, h == 0 ? 1.f : 0.f);
  int k0 = t0 - 128; if (k0 < 0) k0 = 0;
  MaskWin mf{token, t0, 128, 8 * h, 0, 0, true};
  att_stream(smem, st, qf, Kp, 64, Vp, S_, k0 >> 6, t0 >> 6, lane, mf);
  const float inv = att_invl(st);
#pragma unroll
  for (int r = 0; r < 16; ++r) { st.o0[r] *= inv; st.o1[r] *= inv; }
  store_out(st.o0, st.o1, (const bf16_t*)(p.ws + E_ZA) + grow * 512 + head * 64, (bf16_t*)(p.ws + OFF_H) + grow * 1024 + head * 64, h);
}

DI void nsa_unit(const Params& p, char* smem, int u) {
  float* imp_s = (float*)smem;
  float* sc_s = imp_s + 4096;
  unsigned* sel_s = (unsigned*)(sc_s + 32 * 33);
  unsigned* uni_s = sel_s + 32;
  const int tid = tidx(), lane = tid & 63, w = tid >> 6, i = lane & 31, h = lane >> 5;
  const int b = u >> 7, g = (u >> 6) & 1, tt = u & 63, t0 = tt * 32, token = t0 + i, head = g * 4 + w, bg = b * 2 + g;
  const size_t grow = (size_t)b * S_ + token;
  __syncthreads();
  for (int k = tid; k < 4096; k += 256) imp_s[k] = 0.f;
  if (tid == 0) *uni_s = 0u;
  __syncthreads();
  const bf16_t* qp = (const bf16_t*)(p.ws + E_QB) + grow * 512 + head * 64 + 32 * h;
  bf16x8 qf[4];
#pragma unroll
  for (int s = 0; s < 4; ++s) qf[s] = *(const bf16x8*)(qp + 8 * s);
  const float* gl = (const float*)(p.ws + E_GB) + grow * 24 + head * 3;
  const float g0 = 1.f / (1.f + __expf(-gl[0])), g1 = 1.f / (1.f + __expf(-gl[1])), g2 = 1.f / (1.f + __expf(-gl[2]));

  const bf16_t* Kc = (const bf16_t*)(p.ws + OFF_KCMP) + (size_t)bg * 128 * 64;
  const bf16_t* Vc = (const bf16_t*)(p.ws + OFF_VCMPT) + (size_t)bg * 64 * 128;
  const int ntile = (t0 >> 9) + 1;
  float m = NEG_INF, l = 0.f;
  bf16x8 kcur[4];
  load_kf(kcur, Kc, 64, 0, lane);
  for (int T = 0; T < ntile; ++T) {
    bf16x8 knxt[4];
    load_kf(knxt, Kc, 64, (T + 1 < ntile ? T + 1 : 0) * 32, lane);
    const f32x16 sa = qk_mfma(kcur, qf);
#pragma unroll
    for (int s = 0; s < 4; ++s) kcur[s] = knxt[s];
    float pv[16]; float mx = NEG_INF;
#pragma unroll
    for (int r = 0; r < 16; ++r) {
      const int c = T * 32 + 16 * (r >> 3) + 8 * h + (r & 7);
      const float v = (16 * c + 31 <= token) ? sa[r] * SC2 : NEG_INF;
      pv[r] = v; mx = fmaxf(mx, v);
    }
    mx = fmaxf(mx, __shfl_xor(mx, 32));
    const float mnew = fmaxf(m, mx), msafe = (mnew == NEG_INF) ? 0.f : mnew;
    const float alpha = ex2(m - msafe);
    float sum = 0.f;
#pragma unroll
    for (int r = 0; r < 16; ++r) sum += ex2(pv[r] - msafe);
    l = l * alpha + sum; m = mnew;
  }
  l = l + __shfl_xor(l, 32);
  const float invl = l > 0.f ? 1.f / l : 0.f, msafe = (m == NEG_INF) ? 0.f : m;
  f32x16 ot0, ot1;
  {
    f32x16 oc0, oc1;
#pragma unroll
    for (int r = 0; r < 16; ++r) { oc0[r] = 0.f; oc1[r] = 0.f; }
    for (int T = 0; T < ntile; ++T) {
      bf16x8 knxt[4];
      load_kf(knxt, Kc, 64, (T + 1 < ntile ? T + 1 : T) * 32, lane);
      bf16x8 vf[2][2];
      load_v(vf, Vc, 128, T * 32, lane);
      const f32x16 sa = qk_mfma(kcur, qf);
#pragma unroll
      for (int s = 0; s < 4; ++s) kcur[s] = knxt[s];
      float pv[16];
#pragma unroll
      for (int r = 0; r < 16; ++r) {
        const int c = T * 32 + 16 * (r >> 3) + 8 * h + (r & 7);
        pv[r] = (16 * c + 31 <= token) ? ex2(sa[r] * SC2 - msafe) * invl : 0.f;
      }
#pragma unroll
      for (int s2 = 0; s2 < 2; ++s2) {
        const int j0 = 8 * T + 4 * s2 + 2 * h;
        const float a0 = pv[8 * s2] + pv[8 * s2 + 1] + pv[8 * s2 + 2] + pv[8 * s2 + 3];
        const float a1 = pv[8 * s2 + 3] + pv[8 * s2 + 4] + pv[8 * s2 + 5] + pv[8 * s2 + 6] + pv[8 * s2 + 7];
        const float a2 = pv[8 * s2 + 7];
        float* ip = imp_s + (w * 32 + i) * 32 + j0;
        atomicAdd(ip, a0);
        atomicAdd(ip + 1, a1);
        if (j0 + 2 < 32) atomicAdd(ip + 2, a2);
      }
      bf16x8 pf[2];
      pack_p(pv, pf);
#pragma unroll
      for (int s2 = 0; s2 < 2; ++s2) { oc0 = MFMA(vf[0][s2], pf[s2], oc0); oc1 = MFMA(vf[1][s2], pf[s2], oc1); }
    }
#pragma unroll
    for (int r = 0; r < 16; ++r) { ot0[r] = g0 * oc0[r]; ot1[r] = g0 * oc1[r]; }
  }
  __syncthreads();
  const int tb = t0 >> 6;
  {
    const int q = tid >> 3, sub = tid & 7;
    float v[4];
#pragma unroll
    for (int jj = 0; jj < 4; ++jj) {
      const int j = sub * 4 + jj;
      const float im = imp_s[(0 * 32 + q) * 32 + j] + imp_s[(1 * 32 + q) * 32 + j] + imp_s[(2 * 32 + q) * 32 + j] + imp_s[(3 * 32 + q) * 32 + j];
      v[jj] = (j > tb) ? NEG_INF : ((j == 0 || j == tb || j == tb - 1) ? 1e4f : im);
    }
    unsigned msk = 0u;
#pragma unroll 1
    for (int rnd = 0; rnd < 8; ++rnd) {
      float best = NEG_INF; int bi = 99;
#pragma unroll
      for (int jj = 0; jj < 4; ++jj) if (v[jj] > best) { best = v[jj]; bi = sub * 4 + jj; }
#pragma unroll
      for (int o = 1; o < 8; o <<= 1) {
        const float ob = __shfl_xor(best, o); const int oi = __shfl_xor(bi, o);
        if (ob > best || (ob == best && oi < bi)) { best = ob; bi = oi; }
      }
      if (best > NEG_INF) {
        msk |= 1u << bi;
#pragma unroll
        for (int jj = 0; jj < 4; ++jj) if (sub * 4 + jj == bi) v[jj] = NEG_INF;
      }
    }
    if (sub == 0) sel_s[q] = msk;
  }
  __syncthreads();
  const unsigned sel = sel_s[i];
  {
    const bf16_t* Kp = (const bf16_t*)(p.ws + E_KS) + (size_t)b * S_ * 128 + g * 64;
    const bf16_t* Vp = (const bf16_t*)(p.ws + E_VST) + (size_t)bg * 64 * S_;
    Att st; att_init(st, NEG_INF, 0.f);
    MaskSel mf{sel, token, t0, 8 * h, 0, 0, true};
    att_stream(smem, st, qf, Kp, 128, Vp, S_, 0, tb, lane, mf);
    const float inv = att_invl(st) * g1;
#pragma unroll
    for (int r = 0; r < 16; ++r) { ot0[r] += inv * st.o0[r]; ot1[r] += inv * st.o1[r]; }
  }
  {
    const bf16_t* Kp = (const bf16_t*)(p.ws + E_KW) + (size_t)b * S_ * 128 + g * 64;
    const bf16_t* Vp = (const bf16_t*)(p.ws + E_VWT) + (size_t)bg * 64 * S_;
    Att st; att_init(st, NEG_INF, 0.f);
    int k0 = t0 - 512; if (k0 < 0) k0 = 0;
    MaskWin mf{token, t0, 512, 8 * h, 0, 0, true};
    att_stream(smem, st, qf, Kp, 128, Vp, S_, k0 >> 6, tb, lane, mf);
    const float inv = att_invl(st) * g2;
#pragma unroll
    for (int r = 0; r < 16; ++r) { ot0[r] += inv * st.o0[r]; ot1[r] += inv * st.o1[r]; }
  }
  store_out(ot0, ot1, (const bf16_t*)(p.ws + E_ZB) + grow * 512 + head * 64, (bf16_t*)(p.ws + OFF_H) + grow * 1024 + 512 + head * 64, h);
}

DI void kmean_unit(const Params& p, char* smem, int u) {
  float* red = (float*)smem;
  const int tid = tidx(), lane = tid & 63, w = tid >> 6;
  const int b = u >> 6, j = (u >> 3) & 7, cgp = u & 7, col = cgp * 128 + lane * 2;
  const bf16_t* kp = (const bf16_t*)(p.ws + O_K) + ((size_t)b * S_ + j * 256 + w * 64) * 1024 + col;
  float a0 = 0.f, a1 = 0.f;
#pragma unroll 8
  for (int t = 0; t < 64; ++t) { const unsigned v = *(const unsigned*)(kp + (size_t)t * 1024); a0 += bflo(v); a1 += bfhi(v); }
  __syncthreads();
  red[w * 128 + lane * 2] = a0; red[w * 128 + lane * 2 + 1] = a1;
  __syncthreads();
  if (tid < 128) {
    const float v = (red[tid] + red[128 + tid] + red[256 + tid] + red[384 + tid]) * (1.f / 256.f);
    const int c = cgp * 128 + tid, head = c >> 6, d = c & 63;
    ((float*)(p.ws + OFF_KMEAN))[(((size_t)b * 16 + head) * 8 + j) * 64 + d] = v;
  }
}
DI void moba_unit(const Params& p, char* smem, int li, int u) {
  const int lane = tidx() & 63, w = tidx() >> 6, i = lane & 31, h = lane >> 5;
  const int b = u >> 8, head = (u >> 4) & 15, chunk = u & 15, t0 = chunk * 128 + w * 32, token = t0 + i, ob = t0 >> 8;
  const size_t grow = (size_t)b * S_ + token;
  const bf16_t* qp = (const bf16_t*)(p.ws + O_Q) + grow * 1024 + head * 64 + 32 * h;
  bf16x8 qf[4];
#pragma unroll
  for (int s = 0; s < 4; ++s) qf[s] = *(const bf16x8*)(qp + 8 * s);
  const float* km = (const float*)(p.ws + OFF_KMEAN) + (size_t)li * 65536 + ((size_t)b * 16 + head) * 8 * 64 + 32 * h;
  float gs[7];
#pragma unroll
  for (int j = 0; j < 7; ++j) {
    float a = 0.f;
    if (j < ob) {
#pragma unroll
      for (int s = 0; s < 4; ++s) {
        const float4 k0 = *(const float4*)(km + j * 64 + 8 * s), k1 = *(const float4*)(km + j * 64 + 8 * s + 4);
        union { bf16x8 v; unsigned uu[4]; } t; t.v = qf[s];
        a += bflo(t.uu[0]) * k0.x + bfhi(t.uu[0]) * k0.y + bflo(t.uu[1]) * k0.z + bfhi(t.uu[1]) * k0.w;
        a += bflo(t.uu[2]) * k1.x + bfhi(t.uu[2]) * k1.y + bflo(t.uu[3]) * k1.z + bfhi(t.uu[3]) * k1.w;
      }
      a += __shfl_xor(a, 32);
    }
    gs[j] = a;
  }
  unsigned sel = 0u;
  if (ob <= 3) sel = (1u << ob) - 1u;
  else {
#pragma unroll
    for (int rnd = 0; rnd < 3; ++rnd) {
      float best = NEG_INF; int bi = 0;
#pragma unroll
      for (int j = 0; j < 7; ++j) if (j < ob && !((sel >> j) & 1u) && gs[j] > best) { best = gs[j]; bi = j; }
      sel |= 1u << bi;
    }
  }
  const bf16_t* Kp = (const bf16_t*)(p.ws + O_K) + (size_t)b * S_ * 1024 + head * 64;
  const bf16_t* Vp = (const bf16_t*)(p.ws + O_VT) + (size_t)(b * 16 + head) * 64 * S_;
  Att st; att_init(st, NEG_INF, 0.f);
  MaskMoba mf{sel, token, t0, ob, 8 * h, 0, 0, true};
  att_stream(smem, st, qf, Kp, 1024, Vp, S_, 0, chunk * 2 + 1, lane, mf);
  const float inv = att_invl(st);
#pragma unroll
  for (int r = 0; r < 16; ++r) { st.o0[r] *= inv; st.o1[r] *= inv; }
  store_out(st.o0, st.o1, (const bf16_t*)(p.ws + O_Z) + grow * 1024 + head * 64, (bf16_t*)(p.ws + OFF_H) + grow * 1024 + head * 64, h);
}

enum { PH_P0 = 0, PH_NORM, PH_G1, PH_E3, PH_E4, PH_E5, PH_O3, PH_O4, PH_OUT, PH_FINAL, PH_E4A };

typedef const Params __attribute__((address_space(4))) * KParamPtr;
DI void run_phase(char* smem, int ph, int layer, int vb, int nb) {
#if defined(__HIP_DEVICE_COMPILE__)
  KParamPtr kp = (KParamPtr)__builtin_amdgcn_kernarg_segment_ptr();
  asm volatile("" : "+s"(kp), "+s"(vb), "+s"(nb), "+s"(layer));
  Params p;
  __builtin_memcpy(&p, kp, sizeof(Params));
#else
  Params p{};
#endif
  const int li = layer >> 1;
  switch (ph) {
#if !defined(ONLY) || ONLY == 0
    case PH_P0: phase_p0(p, smem, vb, nb); break;
#endif
#if !defined(ONLY) || ONLY == 1
    case PH_NORM: phase_prep0(p, smem, vb, nb); break;
#endif
#if !defined(ONLY) || ONLY == 2
    case PH_G1: if (layer & 1) phase_g1_odd(p, smem, li, vb, nb); else phase_g1_even(p, smem, li, vb, nb); break;
#endif
#if !defined(ONLY) || ONLY == 3
    case PH_E3:
      if (nb > 256) {
        if (vb < 128) mlp1_tile(p, smem, li, vb);
        else for (int u = vb - 128; u < 1024; u += nb - 128) swa_unit(p, smem, li, u);
      } else {
        for (int u = vb; u < 128 + 1024; u += nb) { if (u < 128) mlp1_tile(p, smem, li, u); else swa_unit(p, smem, li, u - 128); }
      }
      break;
#endif
#if !defined(ONLY) || ONLY == 4
    case PH_E4: for (int u = vb; u < 32; u += nb) mlp2_tile(p, smem, li, u); break;
#endif
#if !defined(ONLY) || ONLY == 5
    case PH_E5:
      for (int r = 0; r * nb < 1024; ++r) {
        const int idx = r * nb + ((r & 1) ? nb - 1 - vb : vb);
        if (idx >= 1024) continue;
        const int tt = 63 - (idx >> 4), bgi = idx & 15;
        nsa_unit(p, smem, (bgi << 6) | tt);
      }
      break;
#endif
#if !defined(ONLY) || ONLY == 6
    case PH_O3: for (int u = vb; u < 512; u += nb) kmean_unit(p, smem, u); break;
#endif
#if !defined(ONLY) || ONLY == 7
    case PH_O4:
      for (int r = 0; r * nb < 2048; ++r) {
        const int idx = r * nb + ((r & 1) ? nb - 1 - vb : vb);
        if (idx >= 2048) continue;
        const int chunk = 15 - (idx >> 7), bh = idx & 127;
        moba_unit(p, smem, li, (bh << 4) | chunk);
      }
      break;
#endif
#if !defined(ONLY) || ONLY == 8
    case PH_OUT: phase_out(p, smem, layer, vb, nb); break;
#endif
#if !defined(ONLY) || ONLY == 9
    case PH_FINAL: phase_final(p, vb, nb); break;
#endif
#if !defined(ONLY) || ONLY == 10
    case PH_E4A: break;
#endif
  }
}

constexpr int SMEM_BYTES = 55296;

template <int PH>
__global__ void __launch_bounds__(256, MINW) phase_kernel(Params p, int layer) {
  __shared__ __attribute__((aligned(16))) char smem[SMEM_BYTES];
  run_phase(smem, PH, layer, blockIdx.x, gridDim.x);
}

#define XB_TMO      128
#define XB_XCNT(j)  (256  + 64 * (j))
#define XB_XSUB(j)  (1280 + 64 * (j))
#define XB_XGEN(j)  (2304 + 64 * (j))
#define XB_TOP      3328
#define XB_TOPGEN   3392
#define XCD_BAR_WORDS 3456
#define XB_SPIN_CAP (1u << 18)
#define LAS __attribute__((address_space(3)))
DI unsigned xb_ld(unsigned* p) { return __hip_atomic_load(p, __ATOMIC_RELAXED, __HIP_MEMORY_SCOPE_AGENT); }
DI unsigned xb_add(unsigned* p, unsigned v) { return __hip_atomic_fetch_add(p, v, __ATOMIC_RELAXED, __HIP_MEMORY_SCOPE_AGENT); }
DI unsigned xb_xcc_id() { return (unsigned)__builtin_amdgcn_s_getreg((3 << 11) | 20) & 0xFu; }
#define XB_SPIN(cond, bar) do { unsigned _sp = 0; while (cond) { __builtin_amdgcn_s_sleep(1); \
    if ((++_sp & 255u) == 0u) { if (xb_ld(&(bar)[XB_TMO])) break; if (_sp > XB_SPIN_CAP) { atomicAdd(&(bar)[XB_TMO], 1u); break; } } } } while (0)
struct XcdBarrier { unsigned* bar; unsigned x; volatile LAS unsigned* st; };
DI XcdBarrier xcd_barrier_post(unsigned* bar, volatile LAS unsigned* st) {
  XcdBarrier b; b.bar = bar; b.x = xb_xcc_id(); b.st = st;
  if (threadIdx.x == 0) (void)xb_add(&bar[XB_XCNT(b.x)], 1u);
  return b;
}
DI void xcd_barrier_complete(unsigned* bar, unsigned x, unsigned& nloc, unsigned& nx) {
  const unsigned G = gridDim.x * gridDim.y * gridDim.z;
  unsigned sum, cnt, mine, sp = 0u;
  for (;;) {
    sum = 0u; cnt = 0u; mine = 0u;
#pragma unroll
    for (unsigned j = 0; j < 16; ++j) { const unsigned c = xb_ld(&bar[XB_XCNT(j)]); sum += c; cnt += (c > 0u) ? 1u : 0u; mine = (j == x) ? c : mine; }
    if (sum == G) break;
    __builtin_amdgcn_s_sleep(1);
    if ((++sp & 255u) == 0u) { if (xb_ld(&bar[XB_TMO])) break; if (sp > XB_SPIN_CAP) { atomicAdd(&bar[XB_TMO], 1u); break; } }
  }
  nloc = mine > 0u ? mine : 1u; nx = cnt > 0u ? cnt : 1u;
}
DI void xcd_barrier(const XcdBarrier& b) {
  asm volatile("s_waitcnt vmcnt(0)" ::: "memory");
  __syncthreads();
  if (threadIdx.x == 0) {
    unsigned* bar = b.bar;
    __builtin_amdgcn_s_waitcnt(0);
    unsigned nloc = b.st[0], nx = b.st[1];
    if (nloc == 0u) { xcd_barrier_complete(bar, b.x, nloc, nx); b.st[0] = nloc; b.st[1] = nx; }
    const unsigned old = xb_add(&bar[XB_XSUB(b.x)], 1u);
    const unsigned gen = old / nloc;
    if (old + 1u == (gen + 1u) * nloc) {
      __builtin_amdgcn_fence(__ATOMIC_RELEASE, "agent");
      asm volatile("s_waitcnt vmcnt(0)" ::: "memory");
      const unsigned og = xb_add(&bar[XB_TOP], 1u);
      const unsigned tg = og / nx;
      if (og + 1u == (tg + 1u) * nx) xb_add(&bar[XB_TOPGEN], 1u);
      else XB_SPIN(xb_ld(&bar[XB_TOPGEN]) == tg, bar);
      __builtin_amdgcn_fence(__ATOMIC_ACQUIRE, "agent");
      xb_add(&bar[XB_XGEN(b.x)], 1u);
      asm volatile("s_waitcnt vmcnt(0)" ::: "memory");
    } else {
      XB_SPIN(xb_ld(&bar[XB_XGEN(b.x)]) == gen, bar);
      __builtin_amdgcn_fence(__ATOMIC_ACQUIRE, "agent");
      asm volatile("s_waitcnt vmcnt(0)" ::: "memory");
    }
  }
  __syncthreads();
}

__global__ void __launch_bounds__(256, MINW) mega_kernel(Params p) {
  __shared__ __attribute__((aligned(16))) char smem[SMEM_BYTES];
  cg::grid_group grid = cg::this_grid();
  const int vb = blockIdx.x, nb = gridDim.x;
  __shared__ uint4 xb_words;
  unsigned* bar = (unsigned*)(p.ws + OFF_BAR);
  if (threadIdx.x == 0) xb_words = make_uint4(0u, 0u, 0u, 0u);
  if (vb == 0) for (int k = threadIdx.x; k < XCD_BAR_WORDS; k += 256) __hip_atomic_store(bar + k, 0u, __ATOMIC_RELAXED, __HIP_MEMORY_SCOPE_AGENT);
  __syncthreads();
  run_phase(smem, PH_P0, 0, vb, nb);
  if (PROBE_DUP & 2048) { __syncthreads(); run_phase(smem, PH_P0, 0, vb, nb); }
  grid.sync();
  const XcdBarrier xb = xcd_barrier_post(bar, (volatile LAS unsigned*)&xb_words);
#define GSYNC() xcd_barrier(xb)
  for (int layer = 0; layer < 4; ++layer) {
    if (layer == 0) { run_phase(smem, PH_NORM, layer, vb, nb); GSYNC(); if (PROBE_DUP & 4096) { run_phase(smem, PH_NORM, layer, vb, nb); GSYNC(); } }
    run_phase(smem, PH_G1, layer, vb, nb); GSYNC();
    if (PROBE_DUP & 1) { run_phase(smem, PH_G1, layer, vb, nb); GSYNC(); }
    if (layer & 1) {
      run_phase(smem, PH_O4, layer, vb, nb); GSYNC();
      if (PROBE_DUP & 4) { run_phase(smem, PH_O4, layer, vb, nb); GSYNC(); }
    } else {
      run_phase(smem, PH_E3, layer, vb, nb); GSYNC();
      if (PROBE_DUP & 8) { run_phase(smem, PH_E3, layer, vb, nb); GSYNC(); }
      run_phase(smem, PH_E4, layer, vb, nb); GSYNC();
      run_phase(smem, PH_E5, layer, vb, nb); GSYNC();
      if (PROBE_DUP & 2) { run_phase(smem, PH_E5, layer, vb, nb); GSYNC(); }
    }
    run_phase(smem, PH_OUT, layer, vb, nb); GSYNC();
    if ((PROBE_DUP & 32) && layer == 0) { for (int k = 0; k < 4; ++k) { run_phase(smem, PH_OUT, layer, vb, nb); GSYNC(); } }
  }
  if (PROBE_DUP & 64) { run_phase(smem, PH_P0, 0, vb, nb); GSYNC(); }
  if (PROBE_DUP & 128) { for (int k = 0; k < 20; ++k) GSYNC(); }
  if (PROBE_DUP & 256) { for (int k = 0; k < 4; ++k) { run_phase(smem, PH_O3, 1, vb, nb); GSYNC(); } }
#undef GSYNC
  run_phase(smem, PH_FINAL, 0, vb, nb);
}

extern "C" void kernel_launch(void* const* d_in, const int* in_sizes, int n_in, void* d_out, int out_size, void* d_ws, size_t ws_size,
                              hipStream_t stream) {
  Params p{};
  p.x = (const float*)d_in[0]; p.c = (const float*)d_in[1]; p.w_ada = (const float*)d_in[2]; p.b_ada = (const float*)d_in[3];
  p.norm_g = (const float*)d_in[4]; p.w_in_even = (const float*)d_in[5]; p.a_sinks = (const float*)d_in[6];
  p.pe_k = (const float*)d_in[7]; p.w1k = (const float*)d_in[8]; p.w2k = (const float*)d_in[9];
  p.pe_v = (const float*)d_in[10]; p.w1v = (const float*)d_in[11]; p.w2v = (const float*)d_in[12];
  p.w_out_even = (const float*)d_in[13]; p.w_in_odd = (const float*)d_in[14]; p.w_out_odd = (const float*)d_in[15];
  p.final_g = (const float*)d_in[16];
  p.out = (float*)d_out; p.ws = (char*)d_ws;
#if FUSED
  static int grid_blocks = 0;
  if (!grid_blocks) {
    int dev = 0, cus = 0, per_cu = 0;
    hipGetDevice(&dev);
    hipDeviceGetAttribute(&cus, hipDeviceAttributeMultiprocessorCount, dev);
    hipOccupancyMaxActiveBlocksPerMultiprocessor(&per_cu, mega_kernel, 256, 0);
    if (per_cu > 2) per_cu = 2;
    if (per_cu < 1) per_cu = 1;
    grid_blocks = cus * per_cu;
  }
  void* args[] = {&p};
  hipError_t e = hipLaunchCooperativeKernel((void*)mega_kernel, dim3(grid_blocks), dim3(256), args, 0, stream);
  if (e != hipSuccess) fprintf(stderr, "cooperative launch failed: %s (grid %d)\n", hipGetErrorString(e), grid_blocks);
#else
  const int G = 1024;
#define L(PH, layer) phase_kernel<PH><<<G, 256, 0, stream>>>(p, layer)
  L(PH_P0, 0);
  for (int layer = 0; layer < 4; ++layer) {
    if (layer == 0) L(PH_NORM, layer);
    L(PH_G1, layer); if (PROBE_DUP & 1) L(PH_G1, layer);
    if (layer & 1) { L(PH_O4, layer); if (PROBE_DUP & 4) L(PH_O4, layer); }
    else { L(PH_E3, layer); if (PROBE_DUP & 8) L(PH_E3, layer); L(PH_E4, layer); L(PH_E5, layer); if (PROBE_DUP & 2) L(PH_E5, layer); }
    L(PH_OUT, layer);
  }
  L(PH_FINAL, 0);
#undef L
#endif
}
```

```cpp
#include <hip/hip_runtime.h>
#include <hip/hip_cooperative_groups.h>
#include <stdint.h>
#include <stdio.h>
namespace cg = cooperative_groups;

#ifndef FUSED
#define FUSED 1
#endif
#ifndef PROBE_DUP
#define PROBE_DUP 0
#endif
#ifndef MINW
#define MINW 2
#endif

typedef unsigned short bf16_t;
typedef short bf16x8 __attribute__((ext_vector_type(8)));
typedef float f32x16 __attribute__((ext_vector_type(16)));
typedef unsigned u32x4 __attribute__((ext_vector_type(4)));
typedef unsigned u32x2 __attribute__((ext_vector_type(2)));
typedef float f32x4 __attribute__((ext_vector_type(4)));
#define DI __device__ __forceinline__
#define MFMA(a, b, c) __builtin_amdgcn_mfma_f32_32x32x16_bf16((a), (b), (c), 0, 0, 0)
#define NEG_INF (-__builtin_inff())

constexpr int S_ = 2048, T_ = 16384;
constexpr float SC2 = 0.125f * 1.44269504088896f;
constexpr float LOG2E = 1.44269504088896f;

constexpr size_t MBy = 1u << 20;
constexpr size_t OFF_H = 0;
constexpr size_t OFF_PROJ = 32 * MBy;
constexpr size_t OFF_WIE = 160 * MBy;
constexpr size_t OFF_WIO = 172 * MBy;
constexpr size_t OFF_WOE = 188 * MBy;
constexpr size_t OFF_WOO = 192 * MBy;
constexpr size_t OFF_W1 = 196 * MBy;
constexpr size_t OFF_W2 = 200 * MBy;
constexpr size_t OFF_ADA = 201 * MBy;
constexpr size_t OFF_ROPE = 204 * MBy;
constexpr size_t OFF_PEB = 205 * MBy;
constexpr size_t OFF_HID = 206 * MBy;
constexpr size_t OFF_KCMP = 208 * MBy;
constexpr size_t OFF_VCMPT = 208 * MBy + 512 * 1024;
constexpr size_t OFF_KMEAN = 209 * MBy;
constexpr size_t OFF_BAR = 210 * MBy;
constexpr size_t OFF_A2 = 212 * MBy;
constexpr size_t OFF_ROWSS = 245 * MBy;
constexpr size_t OFF_GG = 246 * MBy;
constexpr size_t OFF_BIAS = 247 * MBy;
constexpr size_t OFF_OWIN = OFF_PROJ + 112 * MBy;
constexpr size_t OFF_PART = OFF_PROJ + 96 * MBy;
constexpr size_t OFF_PEBF = OFF_PEB + 512 * 1024;
constexpr size_t E_QA = OFF_PROJ, E_ZA = OFF_PROJ + 16 * MBy, E_QB = OFF_PROJ + 32 * MBy, E_ZB = OFF_PROJ + 48 * MBy;
constexpr size_t E_KA = OFF_PROJ + 64 * MBy, E_VAT = OFF_PROJ + 66 * MBy, E_KC = OFF_PROJ + 68 * MBy, E_VC = OFF_PROJ + 72 * MBy;
constexpr size_t E_KS = OFF_PROJ + 76 * MBy, E_VST = OFF_PROJ + 80 * MBy, E_KW = OFF_PROJ + 84 * MBy, E_VWT = OFF_PROJ + 88 * MBy;
constexpr size_t E_GB = OFF_PROJ + 92 * MBy;
constexpr size_t O_Q = OFF_PROJ, O_K = OFF_PROJ + 32 * MBy, O_VT = OFF_PROJ + 64 * MBy, O_Z = OFF_PROJ + 96 * MBy;

struct Params {
  const float *x, *c, *w_ada, *b_ada, *norm_g, *w_in_even, *a_sinks, *pe_k, *w1k, *w2k, *pe_v, *w1v, *w2v, *w_out_even, *w_in_odd, *w_out_odd, *final_g;
  float* out;
  char* ws;
};

typedef __bf16 bf16v2 __attribute__((ext_vector_type(2)));
DI unsigned pk2(float lo, float hi) { bf16v2 v = {(__bf16)lo, (__bf16)hi}; return __builtin_bit_cast(unsigned, v); }
DI unsigned f2bf(float x) { return pk2(x, 0.f) & 0xffffu; }
DI float bf2f(unsigned b) { return __uint_as_float(b << 16); }
DI float bflo(unsigned u) { return __uint_as_float(u << 16); }
DI float bfhi(unsigned u) { return __uint_as_float(u & 0xffff0000u); }
DI int tidx() { int t = (int)__builtin_amdgcn_workitem_id_x(); asm volatile("" : "+v"(t)); return t; }
DI int crow(int r, int h) { return (r & 3) + 8 * (r >> 2) + 4 * h; }
DI float siluf(float z) { return z / (1.f + __expf(-z)); }
DI float ex2(float x) { return __builtin_amdgcn_exp2f(x); }

template <class ARow, class Epi>
DI void gemm_tiles(char* smem, const bf16_t* __restrict__ A, ARow arow, const bf16_t* __restrict__ Wt, int ldb, int K, int MT, int NT,
                   int vb, int nb, Epi epi, bool xcd_order = false) {
  bf16_t* As = (bf16_t*)smem;
  bf16_t* Bs = As + 128 * 72;
  const int tid = tidx(), lane = tid & 63, w = tid >> 6, wm = w >> 1, wn = w & 1;
  const int lr = tid >> 3, lc = (tid & 7) * 8;
  const int KT = K >> 6;
  const int i = lane & 31, h = lane >> 5;
  const bool xo = xcd_order && ((nb & 7) == 0) && ((MT & 7) == 0);
  const int t_start = xo ? (vb >> 3) : vb, t_step = xo ? (nb >> 3) : nb, t_total = xo ? (MT >> 3) * NT : MT * NT;
  for (int tile = t_start; tile < t_total; tile += t_step) {
    int tm, tn;
    if (xo) { const int gsz = 8 * NT, gid = tile / gsz, wi = tile - gid * gsz; tm = (vb & 7) * (MT >> 3) + gid * 8 + (wi & 7); tn = wi >> 3; }
    else { tm = tile / NT; tn = tile - tm * NT; }
    const bf16_t* ap0 = A + arow(tm * 128 + lr) + lc;
    const size_t astep = arow(tm * 128 + 32 + lr) - arow(tm * 128 + lr);
    const bf16_t* bp = Wt + (size_t)(tn * 256 + lr) * ldb + lc;
    const size_t bstep = (size_t)32 * ldb;
    u32x4 ra0, ra1, ra2, ra3, rb0, rb1, rb2, rb3, rb4, rb5, rb6, rb7;
#define GLOAD(ko)                                                                                         \
    ra0 = *(const u32x4*)(ap0 + (ko)); ra1 = *(const u32x4*)(ap0 + astep + (ko));                         \
    ra2 = *(const u32x4*)(ap0 + 2 * astep + (ko)); ra3 = *(const u32x4*)(ap0 + 3 * astep + (ko));         \
    rb0 = *(const u32x4*)(bp + (ko)); rb1 = *(const u32x4*)(bp + bstep + (ko));                           \
    rb2 = *(const u32x4*)(bp + 2 * bstep + (ko)); rb3 = *(const u32x4*)(bp + 3 * bstep + (ko));           \
    rb4 = *(const u32x4*)(bp + 4 * bstep + (ko)); rb5 = *(const u32x4*)(bp + 5 * bstep + (ko));           \
    rb6 = *(const u32x4*)(bp + 6 * bstep + (ko)); rb7 = *(const u32x4*)(bp + 7 * bstep + (ko));
    GLOAD(0)
    f32x16 acc[2][2][2];
#pragma unroll
    for (int a = 0; a < 2; ++a)
#pragma unroll
      for (int b = 0; b < 2; ++b)
#pragma unroll
        for (int c = 0; c < 2; ++c)
#pragma unroll
          for (int r = 0; r < 16; ++r) acc[a][b][c][r] = 0.f;
    for (int kt = 0; kt < KT; ++kt) {
      __syncthreads();
      *(u32x4*)(As + (lr) * 72 + lc) = ra0; *(u32x4*)(As + (32 + lr) * 72 + lc) = ra1;
      *(u32x4*)(As + (64 + lr) * 72 + lc) = ra2; *(u32x4*)(As + (96 + lr) * 72 + lc) = ra3;
      *(u32x4*)(Bs + (lr) * 72 + lc) = rb0; *(u32x4*)(Bs + (32 + lr) * 72 + lc) = rb1;
      *(u32x4*)(Bs + (64 + lr) * 72 + lc) = rb2; *(u32x4*)(Bs + (96 + lr) * 72 + lc) = rb3;
      *(u32x4*)(Bs + (128 + lr) * 72 + lc) = rb4; *(u32x4*)(Bs + (160 + lr) * 72 + lc) = rb5;
      *(u32x4*)(Bs + (192 + lr) * 72 + lc) = rb6; *(u32x4*)(Bs + (224 + lr) * 72 + lc) = rb7;
      __syncthreads();
      if (kt + 1 < KT) { const int ko = (kt + 1) * 64; GLOAD(ko) }
#pragma unroll
      for (int s = 0; s < 4; ++s) {
        bf16x8 af[2];
#pragma unroll
        for (int mi = 0; mi < 2; ++mi) af[mi] = *(const bf16x8*)(As + (wm * 64 + mi * 32 + i) * 72 + s * 16 + h * 8);
#pragma unroll
        for (int hf = 0; hf < 2; ++hf) {
          bf16x8 bfr[2];
#pragma unroll
          for (int ni = 0; ni < 2; ++ni) bfr[ni] = *(const bf16x8*)(Bs + (wn * 128 + hf * 64 + ni * 32 + i) * 72 + s * 16 + h * 8);
#pragma unroll
          for (int ni = 0; ni < 2; ++ni)
#pragma unroll
            for (int mi = 0; mi < 2; ++mi) acc[hf][mi][ni] = MFMA(bfr[ni], af[mi], acc[hf][mi][ni]);
        }
      }
    }
#undef GLOAD
    __syncthreads();
    epi(acc[0], tm * 128 + wm * 64, tn * 256 + wn * 128, lane, smem + w * 9216);
    epi(acc[1], tm * 128 + wm * 64, tn * 256 + wn * 128 + 64, lane, smem + w * 9216);
  }
}

DI void stage_flush(const bf16_t* img, bf16_t* dst, int ld, int lane) {
  asm volatile("" ::: "memory");
  const bf16_t* ip = img + (lane >> 3) * 72 + (lane & 7) * 8;
  bf16_t* dp = dst + (size_t)(lane >> 3) * ld + (lane & 7) * 8;
#pragma unroll
  for (int ps = 0; ps < 8; ++ps) {
    const u32x4 q = *(const u32x4*)(ip + ps * 8 * 72);
    *(u32x4*)dp = q;
    dp += 8 * ld;
  }
}
DI void st_rm(const f32x16 (&acc)[2][2], char* wsm, bf16_t* dst, int ld, int lane) {
  bf16_t* img = (bf16_t*)wsm;
  bf16_t* lp = img + (lane & 31) * 72 + 4 * (lane >> 5);
#pragma unroll
  for (int mi = 0; mi < 2; ++mi)
#pragma unroll
    for (int ni = 0; ni < 2; ++ni)
#pragma unroll
      for (int a = 0; a < 4; ++a) {
        uint2 o; o.x = pk2(acc[mi][ni][4 * a], acc[mi][ni][4 * a + 1]); o.y = pk2(acc[mi][ni][4 * a + 2], acc[mi][ni][4 * a + 3]);
        *(uint2*)(lp + (32 * mi * 72 + 32 * ni + 8 * a)) = o;
      }
  stage_flush(img, dst, ld, lane);
}
DI void st_rm_rope(const f32x16 (&acc)[2][2], char* wsm, bf16_t* dst, int ld, int lane, const float* cosT, const float* sinT, int pos0) {
  bf16_t* img = (bf16_t*)wsm;
  const int t = lane & 31, h = lane >> 5;
  bf16_t* lp = img + t * 72 + 4 * h;
  const float* cp = cosT + (pos0 + t) * 32 + 4 * h;
  const float* sp = sinT + (pos0 + t) * 32 + 4 * h;
#pragma unroll
  for (int mi = 0; mi < 2; ++mi)
#pragma unroll
    for (int a = 0; a < 4; ++a) {
      const float4 cs = *(const float4*)(cp + (32 * mi * 32 + 8 * a));
      const float4 sn = *(const float4*)(sp + (32 * mi * 32 + 8 * a));
      const float x10 = acc[mi][0][4 * a], x11 = acc[mi][0][4 * a + 1], x12 = acc[mi][0][4 * a + 2], x13 = acc[mi][0][4 * a + 3];
      const float x20 = acc[mi][1][4 * a], x21 = acc[mi][1][4 * a + 1], x22 = acc[mi][1][4 * a + 2], x23 = acc[mi][1][4 * a + 3];
      uint2 o1, o2;
      o1.x = pk2(x10 * cs.x - x20 * sn.x, x11 * cs.y - x21 * sn.y); o1.y = pk2(x12 * cs.z - x22 * sn.z, x13 * cs.w - x23 * sn.w);
      o2.x = pk2(x20 * cs.x + x10 * sn.x, x21 * cs.y + x11 * sn.y); o2.y = pk2(x22 * cs.z + x12 * sn.z, x23 * cs.w + x13 * sn.w);
      *(uint2*)(lp + (32 * mi * 72 + 8 * a)) = o1;
      *(uint2*)(lp + (32 * mi * 72 + 32 + 8 * a)) = o2;
    }
  stage_flush(img, dst, ld, lane);
}
DI void st_tr(const f32x16 (&acc)[2][2], char* wsm, bf16_t* dst, int ld, int lane, int ztok) {
  bf16_t* img = (bf16_t*)wsm;
  const int t = lane & 31, h = lane >> 5;
  bf16_t* lp = img + 4 * h * 72 + t;
#pragma unroll
  for (int mi = 0; mi < 2; ++mi) {
    const bool z = (32 * mi + t) == ztok;
#pragma unroll
    for (int ni = 0; ni < 2; ++ni)
#pragma unroll
      for (int r = 0; r < 16; ++r) {
        const float v = z ? 0.f : acc[mi][ni][r];
        lp[(32 * ni + (r & 3) + 8 * (r >> 2)) * 72 + 32 * mi] = (bf16_t)f2bf(v);
      }
  }
  stage_flush(img, dst, ld, lane);
}

DI f32x16 qk_scores(const bf16x8 (&qf)[4], const bf16_t* __restrict__ Kp, int kstride, int key0, int lane) {
  const int i = lane & 31, h = lane >> 5;
  const int a = i >> 3, hh = (i >> 2) & 1, b = i & 3;
  const int kperm = 16 * (a >> 1) + 8 * hh + 4 * (a & 1) + b;
  const bf16_t* kr = Kp + (size_t)(key0 + kperm) * kstride + 32 * h;
  bf16x8 kf[4];
#pragma unroll
  for (int s = 0; s < 4; ++s) kf[s] = *(const bf16x8*)(kr + 8 * s);
  f32x16 sa;
#pragma unroll
  for (int r = 0; r < 16; ++r) sa[r] = 0.f;
#pragma unroll
  for (int s = 0; s < 4; ++s) sa = MFMA(kf[s], qf[s], sa);
  return sa;
}
DI void load_kf(bf16x8 (&kf)[4], const bf16_t* __restrict__ Kp, int kstride, int key0, int lane) {
  const int i = lane & 31, h = lane >> 5;
  const int a = i >> 3, hh = (i >> 2) & 1, b = i & 3;
  const int kperm = 16 * (a >> 1) + 8 * hh + 4 * (a & 1) + b;
  const bf16_t* kr = Kp + (size_t)(key0 + kperm) * kstride + 32 * h;
#pragma unroll
  for (int s = 0; s < 4; ++s) kf[s] = *(const bf16x8*)(kr + 8 * s);
}
DI f32x16 qk_mfma(const bf16x8 (&kf)[4], const bf16x8 (&qf)[4]) {
  f32x16 sa;
#pragma unroll
  for (int r = 0; r < 16; ++r) sa[r] = 0.f;
#pragma unroll
  for (int s = 0; s < 4; ++s) sa = MFMA(kf[s], qf[s], sa);
  return sa;
}
DI void load_v(bf16x8 (&vf)[2][2], const bf16_t* __restrict__ Vp, int vstride, int key0, int lane) {
  const int i = lane & 31, h = lane >> 5;
#pragma unroll
  for (int dt = 0; dt < 2; ++dt)
#pragma unroll
    for (int s2 = 0; s2 < 2; ++s2) vf[dt][s2] = *(const bf16x8*)(Vp + (size_t)(32 * dt + i) * vstride + key0 + 16 * s2 + 8 * h);
}
DI void pack_p(const float (&p)[16], bf16x8 (&pf)[2]) {
#pragma unroll
  for (int s2 = 0; s2 < 2; ++s2) {
    union { bf16x8 v; unsigned u[4]; } t;
#pragma unroll
    for (int j = 0; j < 4; ++j) t.u[j] = pk2(p[8 * s2 + 2 * j], p[8 * s2 + 2 * j + 1]);
    pf[s2] = t.v;
  }
}
struct Att { float m, l; f32x16 o0, o1; };
DI void att_init(Att& st, float m0, float l0) {
  st.m = m0; st.l = l0;
#pragma unroll
  for (int r = 0; r < 16; ++r) { st.o0[r] = 0.f; st.o1[r] = 0.f; }
}
template <class MaskF>
DI void att_tile(Att& st, const bf16x8 (&qf)[4], const bf16_t* __restrict__ Kp, int kstride, const bf16_t* __restrict__ Vp, int vstride,
                 int key0, int lane, MaskF mask) {
  const int h = lane >> 5;
  f32x16 sa = qk_scores(qf, Kp, kstride, key0, lane);
  bf16x8 vf[2][2];
  load_v(vf, Vp, vstride, key0, lane);
  float p[16];
  float mx = NEG_INF;
#pragma unroll
  for (int r = 0; r < 16; ++r) {
    const int key = key0 + 16 * (r >> 3) + 8 * h + (r & 7);
    const float v = mask(key) ? sa[r] * SC2 : NEG_INF;
    p[r] = v; mx = fmaxf(mx, v);
  }
  mx = fmaxf(mx, __shfl_xor(mx, 32));
  const float mnew = fmaxf(st.m, mx);
  const float msafe = (mnew == NEG_INF) ? 0.f : mnew;
  const float alpha = ex2(st.m - msafe);
  float sum = 0.f;
#pragma unroll
  for (int r = 0; r < 16; ++r) { const float e = ex2(p[r] - msafe); p[r] = e; sum += e; }
  st.l = st.l * alpha + sum; st.m = mnew;
#pragma unroll
  for (int r = 0; r < 16; ++r) { st.o0[r] *= alpha; st.o1[r] *= alpha; }
  bf16x8 pf[2];
  pack_p(p, pf);
#pragma unroll
  for (int s2 = 0; s2 < 2; ++s2) { st.o0 = MFMA(vf[0][s2], pf[s2], st.o0); st.o1 = MFMA(vf[1][s2], pf[s2], st.o1); }
}
DI float att_invl(const Att& st) { const float l = st.l + __shfl_xor(st.l, 32); return l > 0.f ? 1.f / l : 0.f; }
DI void store_out(const f32x16& o0, const f32x16& o1, const bf16_t* __restrict__ zrow, bf16_t* __restrict__ orow, int h) {
  uint2 zz[8];
#pragma unroll
  for (int k = 0; k < 8; ++k) zz[k] = *(const uint2*)(zrow + 32 * (k >> 2) + 8 * (k & 3) + 4 * h);
#pragma unroll
  for (int dt = 0; dt < 2; ++dt)
#pragma unroll
    for (int a = 0; a < 4; ++a) {
      const int d = 32 * dt + 8 * a + 4 * h;
      const uint2 z2 = zz[dt * 4 + a];
      const f32x16& o = dt ? o1 : o0;
      const float r0 = o[4 * a] * siluf(bflo(z2.x)), r1 = o[4 * a + 1] * siluf(bfhi(z2.x));
      const float r2 = o[4 * a + 2] * siluf(bflo(z2.y)), r3 = o[4 * a + 3] * siluf(bfhi(z2.y));
      uint2 ov; ov.x = pk2(r0, r1); ov.y = pk2(r2, r3);
      *(uint2*)(orow + d) = ov;
    }
}

struct TrTile { const float* src; bf16_t* dst; int ldn, src_col0, nvalid, k0, ldk, n0; };
DI void transpose_pair(char* smem, const TrTile& a, const TrTile& b, bool two) {
  float* ta = (float*)smem;
  float* tb = ta + 64 * 65 + 16;
  const int tid = tidx();
  const int kr0 = tid >> 4, c4 = (tid & 15) * 4;
  float4 va[4], vb4[4];
#pragma unroll
  for (int p = 0; p < 4; ++p) {
    va[p] = make_float4(0.f, 0.f, 0.f, 0.f); vb4[p] = make_float4(0.f, 0.f, 0.f, 0.f);
    if (c4 < a.nvalid) va[p] = *(const float4*)(a.src + (size_t)(a.k0 + kr0 + 16 * p) * a.ldn + a.src_col0 + c4);
    if (two && c4 < b.nvalid) vb4[p] = *(const float4*)(b.src + (size_t)(b.k0 + kr0 + 16 * p) * b.ldn + b.src_col0 + c4);
  }
  __syncthreads();
#pragma unroll
  for (int p = 0; p < 4; ++p) {
    const int kr = kr0 + 16 * p;
    ta[kr * 65 + c4] = va[p].x; ta[kr * 65 + c4 + 1] = va[p].y; ta[kr * 65 + c4 + 2] = va[p].z; ta[kr * 65 + c4 + 3] = va[p].w;
    tb[kr * 65 + c4] = vb4[p].x; tb[kr * 65 + c4 + 1] = vb4[p].y; tb[kr * 65 + c4 + 2] = vb4[p].z; tb[kr * 65 + c4 + 3] = vb4[p].w;
  }
  __syncthreads();
  const int n = tid >> 2, ks = (tid & 3) * 16;
  {
    unsigned o[8];
#pragma unroll
    for (int j = 0; j < 8; ++j) o[j] = pk2(ta[(ks + 2 * j) * 65 + n], ta[(ks + 2 * j + 1) * 65 + n]);
    uint4* dp = (uint4*)(a.dst + (size_t)(a.n0 + n) * a.ldk + a.k0 + ks);
    dp[0] = make_uint4(o[0], o[1], o[2], o[3]);
    dp[1] = make_uint4(o[4], o[5], o[6], o[7]);
  }
  if (two) {
    unsigned o[8];
#pragma unroll
    for (int j = 0; j < 8; ++j) o[j] = pk2(tb[(ks + 2 * j) * 65 + n], tb[(ks + 2 * j + 1) * 65 + n]);
    uint4* dp = (uint4*)(b.dst + (size_t)(b.n0 + n) * b.ldk + b.k0 + ks);
    dp[0] = make_uint4(o[0], o[1], o[2], o[3]);
    dp[1] = make_uint4(o[4], o[5], o[6], o[7]);
  }
}
DI TrTile tr_tile(const Params& p, int t) {
  constexpr int T1 = 2 * 48 * 16, T2 = 2 * 64 * 16, T3 = 2 * 16 * 16, T4 = 2 * 16 * 16, T5 = 4 * 4 * 32;
  TrTile r;
  if (t < T1) {
    const int layer = t / 768, q = t % 768, nt = q >> 4, kt = q & 15;
    int src0, nvalid = 64;
    if (nt < 38) src0 = nt * 64; else if (nt < 46) src0 = 2456 + (nt - 38) * 64; else if (nt == 46) { src0 = 2432; nvalid = 24; } else { src0 = 0; nvalid = 0; }
    r.src = p.w_in_even + (size_t)layer * 1024 * 2968; r.ldn = 2968; r.src_col0 = src0; r.nvalid = nvalid; r.k0 = kt * 64;
    r.dst = (bf16_t*)(p.ws + OFF_WIE) + (size_t)layer * 3072 * 1024; r.ldk = 1024; r.n0 = nt * 64;
  } else if ((t -= T1) < T2) {
    const int layer = t / 1024, q = t % 1024, nt = q >> 4, kt = q & 15;
    r.src = p.w_in_odd + (size_t)layer * 1024 * 4096; r.ldn = 4096; r.src_col0 = nt * 64; r.nvalid = 64; r.k0 = kt * 64;
    r.dst = (bf16_t*)(p.ws + OFF_WIO) + (size_t)layer * 4096 * 1024; r.ldk = 1024; r.n0 = nt * 64;
  } else if ((t -= T2) < T3) {
    const int layer = t / 256, q = t % 256, nt = q >> 4, kt = q & 15;
    r.src = p.w_out_even + (size_t)layer * 1024 * 1024; r.ldn = 1024; r.src_col0 = nt * 64; r.nvalid = 64; r.k0 = kt * 64;
    r.dst = (bf16_t*)(p.ws + OFF_WOE) + (size_t)layer * 1024 * 1024; r.ldk = 1024; r.n0 = nt * 64;
  } else if ((t -= T3) < T4) {
    const int layer = t / 256, q = t % 256, nt = q >> 4, kt = q & 15;
    r.src = p.w_out_odd + (size_t)layer * 1024 * 1024; r.ldn = 1024; r.src_col0 = nt * 64; r.nvalid = 64; r.k0 = kt * 64;
    r.dst = (bf16_t*)(p.ws + OFF_WOO) + (size_t)layer * 1024 * 1024; r.ldk = 1024; r.n0 = nt * 64;
  } else if ((t -= T4) < T5) {
    const int lk = t / 128, q = t % 128, nt = q >> 5, kt = q & 31, layer = lk >> 1, kv = lk & 1;
    r.src = (kv ? p.w1v : p.w1k) + (size_t)layer * 2048 * 256; r.ldn = 256; r.src_col0 = nt * 64; r.nvalid = 64; r.k0 = kt * 64;
    r.dst = (bf16_t*)(p.ws + OFF_W1) + (size_t)lk * 256 * 2048; r.ldk = 2048; r.n0 = nt * 64;
  } else {
    t -= T5;
    const int lk = t / 16, q = t % 16, nt = q >> 2, kt = q & 3, layer = lk >> 1, kv = lk & 1;
    r.src = (kv ? p.w2v : p.w2k) + (size_t)layer * 256 * 64; r.ldn = 64; r.src_col0 = 0; r.nvalid = nt ? 0 : 64; r.k0 = kt * 64;
    r.dst = (bf16_t*)(p.ws + OFF_W2) + (size_t)lk * 256 * 256; r.ldk = 256; r.n0 = nt * 64;
  }
  return r;
}

DI void phase_p0(const Params& p, char* smem, int vb, int nb) {
  const int tid = tidx(), lane = tid & 63, w = tid >> 6;
  constexpr int N_ADA = 192, N_PEB = 64, N_ROPE = 256;
  constexpr int U0 = N_ADA + N_PEB + N_ROPE;
  constexpr int T1 = 2 * 48 * 16, T2 = 2 * 64 * 16, T3 = 2 * 16 * 16, T4 = 2 * 16 * 16, T5 = 4 * 4 * 32, T6 = 4 * 4 * 4;
  constexpr int NU = U0 + T1 + T2 + T3 + T4 + T5 + T6;
  for (int k = vb * 256 + tid; k < 4 * T_; k += nb * 256) ((float*)(p.ws + OFF_ROWSS))[T_ + k] = 0.f;
  for (int k = vb * 256 + tid; k < 2 * 65536; k += nb * 256) ((float*)(p.ws + OFF_KMEAN))[k] = 0.f;
  for (int u = vb; u < NU; u += nb) {
    if (u < N_ADA) {
      float* sc = (float*)smem;
      __syncthreads();
      for (int k = tid; k < 8192; k += 256) sc[k] = siluf(p.c[k]);
      __syncthreads();
      const int l = u / 48, eg = u % 48, e = eg * 64 + lane;
      float acc[8];
#pragma unroll
      for (int b = 0; b < 8; ++b) acc[b] = 0.f;
      const float* wp = p.w_ada + (size_t)l * 1024 * 3072 + e;
#pragma unroll 8
      for (int d0 = w * 256; d0 < w * 256 + 256; d0 += 4) {
        const float w0 = wp[(size_t)d0 * 3072], w1 = wp[(size_t)(d0 + 1) * 3072], w2 = wp[(size_t)(d0 + 2) * 3072], w3 = wp[(size_t)(d0 + 3) * 3072];
#pragma unroll
        for (int b = 0; b < 8; ++b) {
          const float4 cv = *(const float4*)(sc + b * 1024 + d0);
          acc[b] += cv.x * w0 + cv.y * w1 + cv.z * w2 + cv.w * w3;
        }
      }
      __syncthreads();
      float* red = (float*)smem;
#pragma unroll
      for (int b = 0; b < 8; ++b) red[(w * 8 + b) * 64 + lane] = acc[b];
      __syncthreads();
      for (int k = tid; k < 512; k += 256) {
        const int b = k >> 6, ln = k & 63;
        const float v = red[(0 * 8 + b) * 64 + ln] + red[(1 * 8 + b) * 64 + ln] + red[(2 * 8 + b) * 64 + ln] + red[(3 * 8 + b) * 64 + ln];
        const int ee = eg * 64 + ln;
        ((float*)(p.ws + OFF_ADA))[(size_t)(l * 8 + b) * 3072 + ee] = v + p.b_ada[l * 3072 + ee];
      }
    } else if (u < N_ADA + N_PEB) {
      const int uu = u - N_ADA, lk = uu >> 4, ch = uu & 15, layer = lk >> 1, kv = lk & 1;
      const float* pe = (kv ? p.pe_v : p.pe_k) + layer * 2048;
      const float* w1 = (kv ? p.w1v : p.w1k) + (size_t)layer * 2048 * 256;
      float acc = 0.f;
#pragma unroll 16
      for (int k = ch * 128; k < ch * 128 + 128; ++k) acc += pe[k] * w1[(size_t)k * 256 + tid];
      ((float*)(p.ws + OFF_PEB))[(lk * 16 + ch) * 256 + tid] = acc;
    } else if (u < U0) {
      const int idx = (u - N_ADA - N_PEB) * 256 + tid, pos = idx >> 5, j = idx & 31;
      const float inv = powf(10000.f, -(float)(2 * j) / 64.f);
      const float ang = (float)pos * inv;
      ((float*)(p.ws + OFF_ROPE))[idx] = cosf(ang);
      ((float*)(p.ws + OFF_ROPE))[65536 + idx] = sinf(ang);
    } else {
      const int u2 = u + nb;
      const bool two = u2 < NU;
      const TrTile ta = tr_tile(p, u - U0);
      const TrTile tb = tr_tile(p, (two ? u2 : u) - U0);
      transpose_pair(smem, ta, tb, two);
      u += nb;
    }
  }
}

DI float wave_sum(float v) {
#pragma unroll
  for (int o = 32; o > 0; o >>= 1) v += __shfl_xor(v, o);
  return v;
}
DI void phase_prep0(const Params& p, char* smem, int vb, int nb) {
  const int tid = tidx(), lane = tid & 63, w = tid >> 6;
  const float* ada = (const float*)(p.ws + OFF_ADA);
  for (int u = vb; u < 448; u += nb) {
    int l, cg;
    if (u < 96) { l = 0; cg = u; } else if (u < 224) { l = 1; cg = u - 96; } else if (u < 320) { l = 2; cg = u - 224; } else { l = 3; cg = u - 320; }
    const bf16_t* Wt = (l & 1) ? (const bf16_t*)(p.ws + OFF_WIO) + (size_t)(l >> 1) * 4096 * 1024 : (const bf16_t*)(p.ws + OFF_WIE) + (size_t)(l >> 1) * 3072 * 1024;
    float* sh = (float*)smem;
    __syncthreads();
    for (int k = tid; k < 8192; k += 256) sh[k] = ada[(size_t)(l * 8 + (k >> 10)) * 3072 + (k & 1023)];
    __syncthreads();
    float* bias = (float*)(p.ws + OFF_BIAS) + (size_t)l * 8 * 4096;
    for (int j = 0; j < 8; ++j) {
      const int n = cg * 32 + w * 8 + j;
      const u32x4 q0 = *(const u32x4*)(Wt + (size_t)n * 1024 + lane * 16), q1 = *(const u32x4*)(Wt + (size_t)n * 1024 + lane * 16 + 8);
      float wv[16];
#pragma unroll
      for (int e = 0; e < 4; ++e) { wv[2 * e] = bflo(q0[e]); wv[2 * e + 1] = bfhi(q0[e]); wv[8 + 2 * e] = bflo(q1[e]); wv[8 + 2 * e + 1] = bfhi(q1[e]); }
#pragma unroll
      for (int b = 0; b < 8; ++b) {
        float a = 0.f;
#pragma unroll
        for (int e4 = 0; e4 < 4; ++e4) {
          const f32x4 sv = *(const f32x4*)(sh + b * 1024 + lane * 16 + 4 * e4);
          a += sv[0] * wv[4 * e4] + sv[1] * wv[4 * e4 + 1] + sv[2] * wv[4 * e4 + 2] + sv[3] * wv[4 * e4 + 3];
        }
        a = wave_sum(a);
        if (lane == 0) bias[b * 4096 + n] = a;
      }
    }
  }
  for (int k = vb * 256 + tid; k < 1024; k += nb * 256) {
    const float* pb = (const float*)(p.ws + OFF_PEB) + (k >> 8) * 16 * 256 + (k & 255);
    float a = 0.f;
#pragma unroll
    for (int ch = 0; ch < 16; ++ch) a += pb[ch * 256];
    ((float*)(p.ws + OFF_PEBF))[k] = a;
  }
  for (int k = vb * 256 + tid; k < 4 * 8 * 1024; k += nb * 256) {
    const int l = k >> 13, b = (k >> 10) & 7, c = k & 1023;
    ((float*)(p.ws + OFF_GG))[k] = p.norm_g[l * 1024 + c] * (1.f + ada[(size_t)(l * 8 + b) * 3072 + 1024 + c]);
  }
  bf16_t* A2 = (bf16_t*)(p.ws + OFF_A2);
  float* rowss = (float*)(p.ws + OFF_ROWSS);
  float4 gw[4];
#pragma unroll
  for (int k = 0; k < 4; ++k) gw[k] = *(const float4*)(p.norm_g + k * 256 + lane * 4);
  const int rstep = nb * 4;
  for (int row = vb * 4 + w; row < T_; row += 2 * rstep) {
    const int row1 = row + rstep;
    const bool has1 = row1 < T_;
    const float* xr0 = p.x + (size_t)row * 1024;
    const float* xr1 = p.x + (size_t)(has1 ? row1 : row) * 1024;
    float4 v0[4], v1[4], s0[4], s1[4];
#pragma unroll
    for (int k = 0; k < 4; ++k) { v0[k] = *(const float4*)(xr0 + k * 256 + lane * 4); v1[k] = *(const float4*)(xr1 + k * 256 + lane * 4); }
#pragma unroll
    for (int k = 0; k < 4; ++k) {
      s0[k] = *(const float4*)(ada + (size_t)(row >> 11) * 3072 + 1024 + k * 256 + lane * 4);
      s1[k] = *(const float4*)(ada + (size_t)((has1 ? row1 : row) >> 11) * 3072 + 1024 + k * 256 + lane * 4);
    }
    float ss0 = 0.f, ss1 = 0.f;
#pragma unroll
    for (int k = 0; k < 4; ++k) {
      ss0 += v0[k].x * v0[k].x + v0[k].y * v0[k].y + v0[k].z * v0[k].z + v0[k].w * v0[k].w;
      ss1 += v1[k].x * v1[k].x + v1[k].y * v1[k].y + v1[k].z * v1[k].z + v1[k].w * v1[k].w;
    }
    ss0 = wave_sum(ss0); ss1 = wave_sum(ss1);
    if (lane == 0) { rowss[row] = ss0; if (has1) rowss[row1] = ss1; }
#pragma unroll
    for (int k = 0; k < 4; ++k) {
      const int col = k * 256 + lane * 4;
      const float4 g = gw[k];
      uint2 o;
      o.x = pk2(v0[k].x * g.x * (1.f + s0[k].x), v0[k].y * g.y * (1.f + s0[k].y)); o.y = pk2(v0[k].z * g.z * (1.f + s0[k].z), v0[k].w * g.w * (1.f + s0[k].w));
      *(uint2*)(A2 + (size_t)row * 1024 + col) = o;
      if (has1) {
        o.x = pk2(v1[k].x * g.x * (1.f + s1[k].x), v1[k].y * g.y * (1.f + s1[k].y)); o.y = pk2(v1[k].z * g.z * (1.f + s1[k].z), v1[k].w * g.w * (1.f + s1[k].w));
        *(uint2*)(A2 + (size_t)row1 * 1024 + col) = o;
      }
    }
  }
}
DI void phase_final(const Params& p, int vb, int nb) {
  const int lane = tidx() & 63, w = tidx() >> 6;
  const float* rowss = (const float*)(p.ws + OFF_ROWSS) + 4 * T_;
  float4 gw[4];
#pragma unroll
  for (int k = 0; k < 4; ++k) gw[k] = *(const float4*)(p.final_g + k * 256 + lane * 4);
  const int rstep = nb * 4;
  for (int row = vb * 4 + w; row < T_; row += 2 * rstep) {
    const int row1 = row + rstep;
    const bool has1 = row1 < T_;
    float* xr0 = p.out + (size_t)row * 1024;
    float* xr1 = p.out + (size_t)(has1 ? row1 : row) * 1024;
    float4 v0[4], v1[4];
#pragma unroll
    for (int k = 0; k < 4; ++k) { v0[k] = *(const float4*)(xr0 + k * 256 + lane * 4); v1[k] = *(const float4*)(xr1 + k * 256 + lane * 4); }
    const float rs0 = rsqrtf(rowss[row] * (1.f / 1024.f) + 1e-6f), rs1 = rsqrtf(rowss[has1 ? row1 : row] * (1.f / 1024.f) + 1e-6f);
#pragma unroll
    for (int k = 0; k < 4; ++k) {
      const float4 g = gw[k];
      float4 o; o.x = v0[k].x * rs0 * g.x; o.y = v0[k].y * rs0 * g.y; o.z = v0[k].z * rs0 * g.z; o.w = v0[k].w * rs0 * g.w;
      *(float4*)(xr0 + k * 256 + lane * 4) = o;
    }
    if (has1) {
#pragma unroll
      for (int k = 0; k < 4; ++k) {
        const float4 g = gw[k];
        float4 o; o.x = v1[k].x * rs1 * g.x; o.y = v1[k].y * rs1 * g.y; o.z = v1[k].z * rs1 * g.z; o.w = v1[k].w * rs1 * g.w;
        *(float4*)(xr1 + k * 256 + lane * 4) = o;
      }
    }
  }
}
DI void apply_rs_bias(f32x16 (&acc)[2][2], const float* rowss, const float* bias, int row0, int col0, int lane) {
  const int t = lane & 31, h = lane >> 5;
  const float rs0 = rsqrtf(rowss[row0 + t] * (1.f / 1024.f) + 1e-6f), rs1 = rsqrtf(rowss[row0 + 32 + t] * (1.f / 1024.f) + 1e-6f);
#pragma unroll
  for (int ni = 0; ni < 2; ++ni)
#pragma unroll
    for (int a = 0; a < 4; ++a) {
      const f32x4 bv = *(const f32x4*)(bias + col0 + 32 * ni + 8 * a + 4 * h);
#pragma unroll
      for (int bb = 0; bb < 4; ++bb) {
        acc[0][ni][4 * a + bb] = acc[0][ni][4 * a + bb] * rs0 + bv[bb];
        acc[1][ni][4 * a + bb] = acc[1][ni][4 * a + bb] * rs1 + bv[bb];
      }
    }
}

DI void phase_g1_even(const Params& p, char* smem, int li, int vb, int nb) {
  const bf16_t* H = (const bf16_t*)(p.ws + OFF_A2);
  const float* rowss = (const float*)(p.ws + OFF_ROWSS) + (size_t)(2 * li) * T_;
  const float* biasl = (const float*)(p.ws + OFF_BIAS) + (size_t)(2 * li) * 8 * 4096;
  const bf16_t* Wt = (const bf16_t*)(p.ws + OFF_WIE) + (size_t)li * 3072 * 1024;
  const float* cosT = (const float*)(p.ws + OFF_ROPE);
  const float* sinT = cosT + 65536;
  char* ws = p.ws;
  auto epi = [&](f32x16 (&acc)[2][2], int row0, int col0, int lane, char* wsm) {
    const int ct = col0 >> 6, b = row0 >> 11, s0 = row0 & 2047;
    if (ct >= 47) return;
    apply_rs_bias(acc, rowss, biasl + b * 4096, row0, col0, lane);
    int mode;
    bf16_t* dst; int ld;
    if (ct < 8) { mode = 1; dst = (bf16_t*)(ws + E_QA) + (size_t)row0 * 512 + ct * 64; ld = 512; }
    else if (ct == 8) { mode = 1; dst = (bf16_t*)(ws + E_KA) + (size_t)row0 * 64; ld = 64; }
    else if (ct == 9) { mode = 2; dst = (bf16_t*)(ws + E_VAT) + (size_t)b * 64 * 2048 + s0; ld = 2048; }
    else if (ct < 18) { mode = 0; dst = (bf16_t*)(ws + E_ZA) + (size_t)row0 * 512 + (ct - 10) * 64; ld = 512; }
    else if (ct < 26) { mode = 1; dst = (bf16_t*)(ws + E_QB) + (size_t)row0 * 512 + (ct - 18) * 64; ld = 512; }
    else if (ct < 28) { mode = 1; dst = (bf16_t*)(ws + E_KC) + ((size_t)(b * 2 + ct - 26) * 2048 + s0) * 64; ld = 64; }
    else if (ct < 30) { mode = 0; dst = (bf16_t*)(ws + E_VC) + ((size_t)(b * 2 + ct - 28) * 2048 + s0) * 64; ld = 64; }
    else if (ct < 32) { mode = 1; dst = (bf16_t*)(ws + E_KS) + (size_t)row0 * 128 + (ct - 30) * 64; ld = 128; }
    else if (ct < 34) { mode = 2; dst = (bf16_t*)(ws + E_VST) + (size_t)(b * 2 + ct - 32) * 64 * 2048 + s0; ld = 2048; }
    else if (ct < 36) { mode = 1; dst = (bf16_t*)(ws + E_KW) + (size_t)row0 * 128 + (ct - 34) * 64; ld = 128; }
    else if (ct < 38) { mode = 2; dst = (bf16_t*)(ws + E_VWT) + (size_t)(b * 2 + ct - 36) * 64 * 2048 + s0; ld = 2048; }
    else if (ct < 46) { mode = 0; dst = (bf16_t*)(ws + E_ZB) + (size_t)row0 * 512 + (ct - 38) * 64; ld = 512; }
    else if (ct == 46) { mode = 3; dst = nullptr; ld = 0; }
    else { mode = 4; dst = nullptr; ld = 0; }
    if (mode == 0) st_rm(acc, wsm, dst, ld, lane);
    else if (mode == 1) st_rm_rope(acc, wsm, dst, ld, lane, cosT, sinT, s0);
    else if (mode == 2) st_tr(acc, wsm, dst, ld, lane, -1);
    else if (mode == 3) {
      float* GB = (float*)(ws + E_GB);
      const int t = lane & 31, h = lane >> 5;
#pragma unroll
      for (int mi = 0; mi < 2; ++mi)
#pragma unroll
        for (int a = 0; a < 3; ++a) {
          float4 o; o.x = acc[mi][0][4 * a]; o.y = acc[mi][0][4 * a + 1]; o.z = acc[mi][0][4 * a + 2]; o.w = acc[mi][0][4 * a + 3];
          *(float4*)(GB + (size_t)(row0 + 32 * mi + t) * 24 + 8 * a + 4 * h) = o;
        }
    }
  };
  gemm_tiles(smem, H, [](int r) { return (size_t)r * 1024; }, Wt, 1024, 1024, 128, 12, vb, nb, epi, true);
}
DI void phase_g1_odd(const Params& p, char* smem, int li, int vb, int nb) {
  const bf16_t* H = (const bf16_t*)(p.ws + OFF_A2);
  float* kmean = (float*)(p.ws + OFF_KMEAN) + (size_t)li * 65536;
  const float* rowss = (const float*)(p.ws + OFF_ROWSS) + (size_t)(2 * li + 1) * T_;
  const float* biasl = (const float*)(p.ws + OFF_BIAS) + (size_t)(2 * li + 1) * 8 * 4096;
  const bf16_t* Wt = (const bf16_t*)(p.ws + OFF_WIO) + (size_t)li * 4096 * 1024;
  const float* cosT = (const float*)(p.ws + OFF_ROPE);
  const float* sinT = cosT + 65536;
  char* ws = p.ws;
  auto epi = [&](f32x16 (&acc)[2][2], int row0, int col0, int lane, char* wsm) {
    const int ct = col0 >> 6, b = row0 >> 11, s0 = row0 & 2047;
    apply_rs_bias(acc, rowss, biasl + b * 4096, row0, col0, lane);
    if (ct < 32) {
      st_rm_rope(acc, wsm, (bf16_t*)(ws + (ct < 16 ? O_Q : O_K)) + (size_t)row0 * 1024 + (ct & 15) * 64, 1024, lane, cosT, sinT, s0);
      if (ct >= 16) {
        const bf16_t* img = (const bf16_t*)wsm + lane;
        float cs = 0.f;
#pragma unroll 16
        for (int r = 0; r < 64; ++r) cs += bf2f(img[r * 72]);
        atomicAdd(kmean + (((size_t)b * 16 + (ct - 16)) * 8 + (s0 >> 8)) * 64 + lane, cs * (1.f / 256.f));
      }
    }
    else if (ct < 48) st_tr(acc, wsm, (bf16_t*)(ws + O_VT) + (size_t)(b * 16 + ct - 32) * 64 * 2048 + s0, 2048, lane, -1);
    else st_rm(acc, wsm, (bf16_t*)(ws + O_Z) + (size_t)row0 * 1024 + (ct - 48) * 64, 1024, lane);
  };
  gemm_tiles(smem, H, [](int r) { return (size_t)r * 1024; }, Wt, 1024, 1024, 128, 16, vb, nb, epi, true);
}
DI void phase_out(const Params& p, char* smem, int layer, int vb, int nb) {
  const bf16_t* AO = (const bf16_t*)(p.ws + OFF_H);
  const bf16_t* Wt = (const bf16_t*)(p.ws + ((layer & 1) ? OFF_WOO : OFF_WOE)) + (size_t)(layer >> 1) * 1024 * 1024;
  const float* xin = layer == 0 ? p.x : p.out;
  float* xo = p.out;
  const float* ada = (const float*)(p.ws + OFF_ADA);
  bf16_t* A2 = (bf16_t*)(p.ws + OFF_A2);
  float* rowss = (float*)(p.ws + OFF_ROWSS) + (size_t)(layer + 1) * T_;
  const float* ggn = (const float*)(p.ws + OFF_GG) + (size_t)(layer < 3 ? layer + 1 : 3) * 8 * 1024;
  auto epi = [&](const f32x16 (&acc)[2][2], int row0, int col0, int lane, char* wsm) {
    const int t = lane & 31, h = lane >> 5, b = row0 >> 11;
    float* img = (float*)wsm;
    const int rr = lane >> 4, cc = (lane & 15) * 4;
    const f32x4 gate = *(const f32x4*)(ada + (size_t)(layer * 8 + b) * 3072 + 2048 + col0 + cc);
    const f32x4 gg = *(const f32x4*)(ggn + b * 1024 + col0 + cc);
#pragma unroll
    for (int mi = 0; mi < 2; ++mi) {
#pragma unroll
      for (int ni = 0; ni < 2; ++ni)
#pragma unroll
        for (int a = 0; a < 4; ++a) {
          f32x4 o; o[0] = acc[mi][ni][4 * a]; o[1] = acc[mi][ni][4 * a + 1]; o[2] = acc[mi][ni][4 * a + 2]; o[3] = acc[mi][ni][4 * a + 3];
          *(f32x4*)(img + t * 68 + 32 * ni + 8 * a + 4 * h) = o;
        }
      asm volatile("" ::: "memory");
      f32x4 xv[8];
#pragma unroll
      for (int ps = 0; ps < 8; ++ps) xv[ps] = *(const f32x4*)(xin + (size_t)(row0 + 32 * mi + ps * 4 + rr) * 1024 + col0 + cc);
#pragma unroll
      for (int ps = 0; ps < 8; ++ps) {
        const int row = ps * 4 + rr;
        const f32x4 y = *(const f32x4*)(img + row * 68 + cc);
        const size_t o = (size_t)(row0 + 32 * mi + row) * 1024 + col0 + cc;
        const f32x4 xn = xv[ps] + gate * y;
        *(f32x4*)(xo + o) = xn;
        if (layer < 3) { uint2 a2; a2.x = pk2(xn[0] * gg[0], xn[1] * gg[1]); a2.y = pk2(xn[2] * gg[2], xn[3] * gg[3]); *(uint2*)(A2 + o) = a2; }
        float sq = xn[0] * xn[0] + xn[1] * xn[1] + xn[2] * xn[2] + xn[3] * xn[3];
        sq += __shfl_xor(sq, 1); sq += __shfl_xor(sq, 2); sq += __shfl_xor(sq, 4); sq += __shfl_xor(sq, 8);
        if ((lane & 15) == 0) atomicAdd(rowss + row0 + 32 * mi + row, sq);
      }
      asm volatile("" ::: "memory");
    }
  };
  gemm_tiles(smem, AO, [](int r) { return (size_t)r * 1024; }, Wt, 1024, 1024, 128, 4, vb, nb, epi, true);
}

DI void mlp1_tile(const Params& p, char* smem, int li, int t) {
  const int ks = t & 3, kv = t >> 6, tt = (t >> 2) & 15, lk = li * 2 + kv;
  const bf16_t* A = (const bf16_t*)(p.ws + (kv ? E_VC : E_KC)) + ks * 512;
  const bf16_t* Wt = (const bf16_t*)(p.ws + OFF_W1) + (size_t)lk * 256 * 2048 + ks * 512;
  float* part = (float*)(p.ws + OFF_PART) + (size_t)(ks * 2 + kv) * 2048 * 256;
  auto epi = [&](const f32x16 (&acc)[2][2], int row0, int col0, int lane, char* wsm) {
    const int t2 = lane & 31, h = lane >> 5;
#pragma unroll
    for (int mi = 0; mi < 2; ++mi)
#pragma unroll
      for (int ni = 0; ni < 2; ++ni)
#pragma unroll
        for (int a = 0; a < 4; ++a) {
          f32x4 o; o[0] = acc[mi][ni][4 * a]; o[1] = acc[mi][ni][4 * a + 1]; o[2] = acc[mi][ni][4 * a + 2]; o[3] = acc[mi][ni][4 * a + 3];
          *(f32x4*)(part + (size_t)(row0 + 32 * mi + t2) * 256 + col0 + 32 * ni + 8 * a + 4 * h) = o;
        }
  };
  gemm_tiles(smem, A, [](int r) { return (size_t)(r >> 7) * 131072 + (size_t)(r & 127) * 1024; }, Wt, 2048, 512, 16, 1, tt, 1 << 30, epi);
}
DI void hid_rows(const Params& p, int li, int kv, int row_base) {
  const float* part = (const float*)(p.ws + OFF_PART);
  bf16_t* Hd = (bf16_t*)(p.ws + OFF_HID);
  const int base_idx = (kv * 2048 + row_base) * 64;
  constexpr size_t PSTR = (size_t)2 * 2048 * 256;
  const float* pebf = (const float*)(p.ws + OFF_PEBF) + (li * 2 + kv) * 256;
  for (int j0 = tidx(); j0 < 128 * 64; j0 += 4 * 256) {
    f32x4 pv[4][5];
#pragma unroll
    for (int q = 0; q < 4; ++q) {
      const int idx = base_idx + j0 + q * 256;
      const size_t e = (size_t)idx * 4;
#pragma unroll
      for (int k = 0; k < 4; ++k) pv[q][k] = *(const f32x4*)(part + k * PSTR + e);
      pv[q][4] = *(const f32x4*)(pebf + (idx & 63) * 4);
    }
#pragma unroll
    for (int q = 0; q < 4; ++q) {
      const int idx = base_idx + j0 + q * 256;
      const size_t e = (size_t)idx * 4;
      const f32x4 v = (pv[q][0] + pv[q][1]) + (pv[q][2] + pv[q][3]) + pv[q][4];
      float g[4];
#pragma unroll
      for (int bb = 0; bb < 4; ++bb) {
        const float xv = v[bb];
        const float uu = 0.7978845608028654f * (xv + 0.044715f * xv * xv * xv);
        const float th = 1.f - 2.f / (__expf(2.f * uu) + 1.f);
        g[bb] = 0.5f * xv * (1.f + th);
      }
      uint2 o; o.x = pk2(g[0], g[1]); o.y = pk2(g[2], g[3]);
      *(uint2*)(Hd + e) = o;
    }
  }
  asm volatile("s_waitcnt vmcnt(0)" ::: "memory");
  __syncthreads();
}
DI void mlp2_tile(const Params& p, char* smem, int li, int t) {
  const int kv = t >> 4, tt = t & 15, lk = li * 2 + kv;
  hid_rows(p, li, kv, tt * 128);
  const bf16_t* A = (const bf16_t*)(p.ws + OFF_HID) + (size_t)kv * 2048 * 256;
  const bf16_t* Wt = (const bf16_t*)(p.ws + OFF_W2) + (size_t)lk * 256 * 256;
  bf16_t* KC = (bf16_t*)(p.ws + OFF_KCMP);
  bf16_t* VT = (bf16_t*)(p.ws + OFF_VCMPT);
  auto epi = [&](const f32x16 (&acc)[2][2], int row0, int col0, int lane, char* wsm) {
    if (col0 != 0) return;
    const int bg = row0 >> 7, c0 = row0 & 127;
    if (kv == 0) {
      f32x16 g[2][2];
      const int t = lane & 31;
#pragma unroll
      for (int mi = 0; mi < 2; ++mi)
#pragma unroll
        for (int ni = 0; ni < 2; ++ni)
#pragma unroll
          for (int r = 0; r < 16; ++r) g[mi][ni][r] = (c0 + 32 * mi + t == 127) ? 0.f : acc[mi][ni][r];
      st_rm(g, wsm, KC + (size_t)row0 * 64, 64, lane);
    } else {
      st_tr(acc, wsm, VT + (size_t)bg * 64 * 128 + c0, 128, lane, 127 - c0);
    }
  };
  gemm_tiles(smem, A, [](int r) { return (size_t)r * 256; }, Wt, 256, 256, 16, 1, tt, 1 << 30, epi);
}

constexpr float LAZY = 6.f;
#define TILE_ISSUE(key0_)                                                          \
  do {                                                                             \
    const int kk_ = (key0_);                                                       \
    gk0 = *(const u32x4*)(K + (size_t)(kk_ + ldr) * kstride + ldc);                \
    gk1 = *(const u32x4*)(K + (size_t)(kk_ + ldr + 32) * kstride + ldc);           \
    gv0 = *(const u32x4*)(V + (size_t)(ldr) * vstride + kk_ + ldc);                \
    gv1 = *(const u32x4*)(V + (size_t)(ldr + 32) * vstride + kk_ + ldc);           \
  } while (0)
#define TILE_STORE(Kb_)                                                            \
  do {                                                                             \
    bf16_t* kb_ = (Kb_);                                                           \
    *(u32x4*)(kb_ + ldr * 72 + ldc) = gk0;                                         \
    *(u32x4*)(kb_ + (ldr + 32) * 72 + ldc) = gk1;                                  \
    *(u32x4*)(kb_ + 64 * 72 + ldr * 72 + ldc) = gv0;                               \
    *(u32x4*)(kb_ + 64 * 72 + (ldr + 32) * 72 + ldc) = gv1;                        \
  } while (0)
template <int MODE, class MF>
DI void att_tile64(Att& st, const bf16x8 (&qf)[4], const bf16_t* Kb, const bf16_t* Vb, int lane, const MF& mf) {
  const int i = lane & 31, h = lane >> 5;
  const int a = i >> 3, hh = (i >> 2) & 1, b = i & 3;
  const int kperm = 16 * (a >> 1) + 8 * hh + 4 * (a & 1) + b;
  f32x16 sa[2];
#pragma unroll
  for (int sub = 0; sub < 2; ++sub) {
#pragma unroll
    for (int r = 0; r < 16; ++r) sa[sub][r] = 0.f;
#pragma unroll
    for (int s = 0; s < 4; ++s) {
      const bf16x8 kf = *(const bf16x8*)(Kb + (32 * sub + kperm) * 72 + 32 * h + 8 * s);
      sa[sub] = MFMA(kf, qf[s], sa[sub]);
    }
  }
  float mx = NEG_INF;
#pragma unroll
  for (int sub = 0; sub < 2; ++sub)
#pragma unroll
    for (int r = 0; r < 16; ++r) {
      if (MODE == 2 || MODE == 4) {
        const int c = 32 * sub + 16 * (r >> 3) + (r & 7);
        bool ok = c <= mf.lim_hi;
        if (MODE == 4) ok = ok && (c > mf.lim_lo);
        if (!ok) sa[sub][r] = NEG_INF;
      }
      mx = fmaxf(mx, sa[sub][r]);
    }
  mx = fmaxf(mx, __shfl_xor(mx, 32)) * SC2;
  if (MODE == 3) mx = mf.on ? mx : NEG_INF;
  const bool upd = mx > st.m + LAZY;
  if (__any(upd)) {
    const float mnew = upd ? mx : st.m;
    const float alpha = upd ? ex2(st.m - mnew) : 1.f;
    st.m = mnew; st.l *= alpha;
#pragma unroll
    for (int r = 0; r < 16; ++r) { st.o0[r] *= alpha; st.o1[r] *= alpha; }
  }
  float nm = (st.m == NEG_INF) ? 0.f : -st.m;
  if (MODE == 3) nm = mf.on ? nm : NEG_INF;
  float sum = 0.f;
#pragma unroll
  for (int sub = 0; sub < 2; ++sub)
#pragma unroll
    for (int r = 0; r < 16; ++r) { const float e = ex2(__builtin_fmaf(sa[sub][r], SC2, nm)); sa[sub][r] = e; sum += e; }
  st.l += sum;
#pragma unroll
  for (int sub = 0; sub < 2; ++sub)
#pragma unroll
    for (int s2 = 0; s2 < 2; ++s2) {
      union { bf16x8 v; unsigned u[4]; } t;
#pragma unroll
      for (int j = 0; j < 4; ++j) t.u[j] = pk2(sa[sub][8 * s2 + 2 * j], sa[sub][8 * s2 + 2 * j + 1]);
      const bf16x8 vf0 = *(const bf16x8*)(Vb + (i) * 72 + 32 * sub + 16 * s2 + 8 * h);
      const bf16x8 vf1 = *(const bf16x8*)(Vb + (32 + i) * 72 + 32 * sub + 16 * s2 + 8 * h);
      st.o0 = MFMA(vf0, t.v, st.o0);
      st.o1 = MFMA(vf1, t.v, st.o1);
    }
}
template <class MF>
DI void att_stream(char* smem, Att& st, const bf16x8 (&qf)[4], const bf16_t* __restrict__ K, int kstride, const bf16_t* __restrict__ V, int vstride,
                   int tlo, int thi, int lane, MF& mf) {
  bf16_t* base = (bf16_t*)smem;
  u32x4 gk0, gk1, gv0, gv1;
  const int ldt = tidx(), ldr = ldt >> 3, ldc = (ldt & 7) * 8;
  __syncthreads();
  TILE_ISSUE(tlo * 64);
  TILE_STORE(base);
  TILE_ISSUE(((tlo + 1 <= thi) ? tlo + 1 : tlo) * 64);
  __syncthreads();
  for (int t = tlo; t <= thi; ++t) {
    const int cur = (t - tlo) & 1;
    bf16_t* Kb = base + cur * (2 * 64 * 72);
    bf16_t* Kn = base + (cur ^ 1) * (2 * 64 * 72);
    if (t + 1 <= thi) TILE_STORE(Kn);
    if (t + 2 <= thi) TILE_ISSUE((t + 2) * 64);
    const int c = mf.cls(t * 64);
    if (c == 1) att_tile64<1>(st, qf, Kb, Kb + 64 * 72, lane, mf);
    else if (c == 2) att_tile64<2>(st, qf, Kb, Kb + 64 * 72, lane, mf);
    else if (c == 3) att_tile64<3>(st, qf, Kb, Kb + 64 * 72, lane, mf);
    else if (c == 4) att_tile64<4>(st, qf, Kb, Kb + 64 * 72, lane, mf);
    __syncthreads();
  }
}
struct MaskWin {
  int token, t0, win, h8; int lim_hi, lim_lo; bool on;
  DI int cls(int key0) {
    if (key0 > t0 + 31 || key0 + 63 <= t0 - win) return 0;
    const bool lo_ok = key0 > t0 + 31 - win;
    if (key0 + 63 <= t0 && lo_ok) return 1;
    lim_hi = token - key0 - h8; lim_lo = token - win - key0 - h8;
    return lo_ok ? 2 : 4;
  }
};
struct MaskSel {
  unsigned sel; int token, t0, h8; int lim_hi, lim_lo; bool on;
  DI int cls(int key0) {
    on = (sel >> (key0 >> 6)) & 1u;
    const unsigned long long bal = __ballot(on);
    if (bal == 0ull || key0 > t0 + 31) return 0;
    if (key0 + 63 <= t0) return bal == ~0ull ? 1 : 3;
    lim_hi = on ? token - key0 - h8 : -1;
    return 2;
  }
};
struct MaskMoba {
  unsigned sel; int token, t0, ob, h8; int lim_hi, lim_lo; bool on;
  DI int cls(int key0) {
    if (key0 < ob * 256) {
      on = (sel >> (key0 >> 8)) & 1u;
      const unsigned long long bal = __ballot(on);
      return bal == 0ull ? 0 : (bal == ~0ull ? 1 : 3);
    }
    if (key0 > t0 + 31) return 0;
    if (key0 + 63 <= t0) return 1;
    lim_hi = token - key0 - h8;
    return 2;
  }
};

DI void swa_unit(const Params& p, char* smem, int li, int u) {
  const int lane = tidx() & 63, w = tidx() >> 6, i = lane & 31, h = lane >> 5;
  const int b = u >> 7, tt = (u >> 1) & 63, hg = u & 1, head = hg * 4 + w, t0 = tt * 32, token = t0 + i;
  const size_t grow = (size_t)b * S_ + token;
  const bf16_t* qp = (const bf16_t*)(p.ws + E_QA) + grow * 512 + head * 64 + 32 * h;
  bf16x8 qf[4];
#pragma unroll
  for (int s = 0; s < 4; ++s) qf[s] = *(const bf16x8*)(qp + 8 * s);
  const bf16_t* Kp = (const bf16_t*)(p.ws + E_KA) + (size_t)b * S_ * 64;
  const bf16_t* Vp = (const bf16_t*)(p.ws + E_VAT) + (size_t)b * 64 * S_;
  Att st;
  att_init(st, p.a_sinks[li * 8 + head] * LOG2E, h == 0 ? 1.f : 0.f);
  int k0 = t0 - 128; if (k0 < 0) k0 = 0;
  MaskWin mf{token, t0, 128, 8 * h, 0, 0, true};
  att_stream(smem, st, qf, Kp, 64, Vp, S_, k0 >> 6, t0 >> 6, lane, mf);
  const float inv = att_invl(st);
#pragma unroll
  for (int r = 0; r < 16; ++r) { st.o0[r] *= inv; st.o1[r] *= inv; }
  store_out(st.o0, st.o1, (const bf16_t*)(p.ws + E_ZA) + grow * 512 + head * 64, (bf16_t*)(p.ws + OFF_H) + grow * 1024 + head * 64, h);
}

DI void nsa_win_unit(const Params& p, char* smem, int u) {
  const int tid = tidx(), lane = tid & 63, w = tid >> 6, i = lane & 31, h = lane >> 5;
  const int b = u >> 7, g = (u >> 6) & 1, tt = u & 63, t0 = tt * 32, token = t0 + i, head = g * 4 + w, bg = b * 2 + g;
  const size_t grow = (size_t)b * S_ + token;
  const bf16_t* qp = (const bf16_t*)(p.ws + E_QB) + grow * 512 + head * 64 + 32 * h;
  bf16x8 qf[4];
#pragma unroll
  for (int s = 0; s < 4; ++s) qf[s] = *(const bf16x8*)(qp + 8 * s);
  const float gl2 = ((const float*)(p.ws + E_GB))[grow * 24 + head * 3 + 2];
  const float g2 = 1.f / (1.f + __expf(-gl2));
  const bf16_t* Kp = (const bf16_t*)(p.ws + E_KW) + (size_t)b * S_ * 128 + g * 64;
  const bf16_t* Vp = (const bf16_t*)(p.ws + E_VWT) + (size_t)bg * 64 * S_;
  Att st; att_init(st, NEG_INF, 0.f);
  int k0 = t0 - 512; if (k0 < 0) k0 = 0;
  MaskWin mf{token, t0, 512, 8 * h, 0, 0, true};
  att_stream(smem, st, qf, Kp, 128, Vp, S_, k0 >> 6, t0 >> 6, lane, mf);
  const float inv = att_invl(st) * g2;
  bf16_t* ow = (bf16_t*)(p.ws + OFF_OWIN) + grow * 512 + head * 64 + 4 * h;
#pragma unroll
  for (int a = 0; a < 4; ++a) {
    u32x2 o0, o1;
    o0[0] = pk2(st.o0[4 * a] * inv, st.o0[4 * a + 1] * inv); o0[1] = pk2(st.o0[4 * a + 2] * inv, st.o0[4 * a + 3] * inv);
    o1[0] = pk2(st.o1[4 * a] * inv, st.o1[4 * a + 1] * inv); o1[1] = pk2(st.o1[4 * a + 2] * inv, st.o1[4 * a + 3] * inv);
    *(u32x2*)(ow + 8 * a) = o0;
    *(u32x2*)(ow + 32 + 8 * a) = o1;
  }
}
DI void nsa_unit(const Params& p, char* smem, int u) {
  float* imp_s = (float*)smem;
  float* sc_s = imp_s + 4096;
  unsigned* sel_s = (unsigned*)(sc_s + 32 * 33);
  unsigned* uni_s = sel_s + 32;
  const int tid = tidx(), lane = tid & 63, w = tid >> 6, i = lane & 31, h = lane >> 5;
  const int b = u >> 7, g = (u >> 6) & 1, tt = u & 63, t0 = tt * 32, token = t0 + i, head = g * 4 + w, bg = b * 2 + g;
  const size_t grow = (size_t)b * S_ + token;
  __syncthreads();
  for (int k = tid; k < 4096; k += 256) imp_s[k] = 0.f;
  if (tid == 0) *uni_s = 0u;
  __syncthreads();
  const bf16_t* qp = (const bf16_t*)(p.ws + E_QB) + grow * 512 + head * 64 + 32 * h;
  bf16x8 qf[4];
#pragma unroll
  for (int s = 0; s < 4; ++s) qf[s] = *(const bf16x8*)(qp + 8 * s);
  const float* gl = (const float*)(p.ws + E_GB) + grow * 24 + head * 3;
  const float g0 = 1.f / (1.f + __expf(-gl[0])), g1 = 1.f / (1.f + __expf(-gl[1])), g2 = 1.f / (1.f + __expf(-gl[2]));

  const bf16_t* Kc = (const bf16_t*)(p.ws + OFF_KCMP) + (size_t)bg * 128 * 64;
  const bf16_t* Vc = (const bf16_t*)(p.ws + OFF_VCMPT) + (size_t)bg * 64 * 128;
  const int ntile = (t0 >> 9) + 1;
  float m = NEG_INF, l = 0.f;
  bf16x8 kcur[4];
  load_kf(kcur, Kc, 64, 0, lane);
  for (int T = 0; T < ntile; ++T) {
    bf16x8 knxt[4];
    load_kf(knxt, Kc, 64, (T + 1 < ntile ? T + 1 : 0) * 32, lane);
    const f32x16 sa = qk_mfma(kcur, qf);
#pragma unroll
    for (int s = 0; s < 4; ++s) kcur[s] = knxt[s];
    float pv[16]; float mx = NEG_INF;
#pragma unroll
    for (int r = 0; r < 16; ++r) {
      const int c = T * 32 + 16 * (r >> 3) + 8 * h + (r & 7);
      const float v = (16 * c + 31 <= token) ? sa[r] * SC2 : NEG_INF;
      pv[r] = v; mx = fmaxf(mx, v);
    }
    mx = fmaxf(mx, __shfl_xor(mx, 32));
    const float mnew = fmaxf(m, mx), msafe = (mnew == NEG_INF) ? 0.f : mnew;
    const float alpha = ex2(m - msafe);
    float sum = 0.f;
#pragma unroll
    for (int r = 0; r < 16; ++r) sum += ex2(pv[r] - msafe);
    l = l * alpha + sum; m = mnew;
  }
  l = l + __shfl_xor(l, 32);
  const float invl = l > 0.f ? 1.f / l : 0.f, msafe = (m == NEG_INF) ? 0.f : m;
  f32x16 ot0, ot1;
  {
    f32x16 oc0, oc1;
#pragma unroll
    for (int r = 0; r < 16; ++r) { oc0[r] = 0.f; oc1[r] = 0.f; }
    for (int T = 0; T < ntile; ++T) {
      bf16x8 knxt[4];
      load_kf(knxt, Kc, 64, (T + 1 < ntile ? T + 1 : T) * 32, lane);
      bf16x8 vf[2][2];
      load_v(vf, Vc, 128, T * 32, lane);
      const f32x16 sa = qk_mfma(kcur, qf);
#pragma unroll
      for (int s = 0; s < 4; ++s) kcur[s] = knxt[s];
      float pv[16];
#pragma unroll
      for (int r = 0; r < 16; ++r) {
        const int c = T * 32 + 16 * (r >> 3) + 8 * h + (r & 7);
        pv[r] = (16 * c + 31 <= token) ? ex2(sa[r] * SC2 - msafe) * invl : 0.f;
      }
#pragma unroll
      for (int s2 = 0; s2 < 2; ++s2) {
        const int j0 = 8 * T + 4 * s2 + 2 * h;
        const float a0 = pv[8 * s2] + pv[8 * s2 + 1] + pv[8 * s2 + 2] + pv[8 * s2 + 3];
        const float a1 = pv[8 * s2 + 3] + pv[8 * s2 + 4] + pv[8 * s2 + 5] + pv[8 * s2 + 6] + pv[8 * s2 + 7];
        const float a2 = pv[8 * s2 + 7];
        float* ip = imp_s + (w * 32 + i) * 32 + j0;
        atomicAdd(ip, a0);
        atomicAdd(ip + 1, a1);
        if (j0 + 2 < 32) atomicAdd(ip + 2, a2);
      }
      bf16x8 pf[2];
      pack_p(pv, pf);
#pragma unroll
      for (int s2 = 0; s2 < 2; ++s2) { oc0 = MFMA(vf[0][s2], pf[s2], oc0); oc1 = MFMA(vf[1][s2], pf[s2], oc1); }
    }
#pragma unroll
    for (int r = 0; r < 16; ++r) { ot0[r] = g0 * oc0[r]; ot1[r] = g0 * oc1[r]; }
  }
  __syncthreads();
  const int tb = t0 >> 6;
  {
    const int q = tid >> 3, sub = tid & 7;
    float v[4];
#pragma unroll
    for (int jj = 0; jj < 4; ++jj) {
      const int j = sub * 4 + jj;
      const float im = imp_s[(0 * 32 + q) * 32 + j] + imp_s[(1 * 32 + q) * 32 + j] + imp_s[(2 * 32 + q) * 32 + j] + imp_s[(3 * 32 + q) * 32 + j];
      v[jj] = (j > tb) ? NEG_INF : ((j == 0 || j == tb || j == tb - 1) ? 1e4f : im);
    }
    unsigned msk = 0u;
#pragma unroll 1
    for (int rnd = 0; rnd < 8; ++rnd) {
      float best = NEG_INF; int bi = 99;
#pragma unroll
      for (int jj = 0; jj < 4; ++jj) if (v[jj] > best) { best = v[jj]; bi = sub * 4 + jj; }
#pragma unroll
      for (int o = 1; o < 8; o <<= 1) {
        const float ob = __shfl_xor(best, o); const int oi = __shfl_xor(bi, o);
        if (ob > best || (ob == best && oi < bi)) { best = ob; bi = oi; }
      }
      if (best > NEG_INF) {
        msk |= 1u << bi;
#pragma unroll
        for (int jj = 0; jj < 4; ++jj) if (sub * 4 + jj == bi) v[jj] = NEG_INF;
      }
    }
    if (sub == 0) sel_s[q] = msk;
  }
  __syncthreads();
  const unsigned sel = sel_s[i];
  {
    const bf16_t* Kp = (const bf16_t*)(p.ws + E_KS) + (size_t)b * S_ * 128 + g * 64;
    const bf16_t* Vp = (const bf16_t*)(p.ws + E_VST) + (size_t)bg * 64 * S_;
    Att st; att_init(st, NEG_INF, 0.f);
    MaskSel mf{sel, token, t0, 8 * h, 0, 0, true};
    att_stream(smem, st, qf, Kp, 128, Vp, S_, 0, tb, lane, mf);
    const float inv = att_invl(st) * g1;
#pragma unroll
    for (int r = 0; r < 16; ++r) { ot0[r] += inv * st.o0[r]; ot1[r] += inv * st.o1[r]; }
  }
  {
    const bf16_t* ow = (const bf16_t*)(p.ws + OFF_OWIN) + grow * 512 + head * 64 + 4 * h;
    u32x2 wv[8];
#pragma unroll
    for (int k = 0; k < 8; ++k) wv[k] = *(const u32x2*)(ow + 32 * (k >> 2) + 8 * (k & 3));
#pragma unroll
    for (int a = 0; a < 4; ++a) {
      ot0[4 * a] += bflo(wv[a][0]); ot0[4 * a + 1] += bfhi(wv[a][0]); ot0[4 * a + 2] += bflo(wv[a][1]); ot0[4 * a + 3] += bfhi(wv[a][1]);
      ot1[4 * a] += bflo(wv[4 + a][0]); ot1[4 * a + 1] += bfhi(wv[4 + a][0]); ot1[4 * a + 2] += bflo(wv[4 + a][1]); ot1[4 * a + 3] += bfhi(wv[4 + a][1]);
    }
  }
  store_out(ot0, ot1, (const bf16_t*)(p.ws + E_ZB) + grow * 512 + head * 64, (bf16_t*)(p.ws + OFF_H) + grow * 1024 + 512 + head * 64, h);
}

DI void kmean_unit(const Params& p, char* smem, int u) {
  float* red = (float*)smem;
  const int tid = tidx(), lane = tid & 63, w = tid >> 6;
  const int b = u >> 6, j = (u >> 3) & 7, cgp = u & 7, col = cgp * 128 + lane * 2;
  const bf16_t* kp = (const bf16_t*)(p.ws + O_K) + ((size_t)b * S_ + j * 256 + w * 64) * 1024 + col;
  float a0 = 0.f, a1 = 0.f;
#pragma unroll 8
  for (int t = 0; t < 64; ++t) { const unsigned v = *(const unsigned*)(kp + (size_t)t * 1024); a0 += bflo(v); a1 += bfhi(v); }
  __syncthreads();
  red[w * 128 + lane * 2] = a0; red[w * 128 + lane * 2 + 1] = a1;
  __syncthreads();
  if (tid < 128) {
    const float v = (red[tid] + red[128 + tid] + red[256 + tid] + red[384 + tid]) * (1.f / 256.f);
    const int c = cgp * 128 + tid, head = c >> 6, d = c & 63;
    ((float*)(p.ws + OFF_KMEAN))[(((size_t)b * 16 + head) * 8 + j) * 64 + d] = v;
  }
}
DI void moba_unit(const Params& p, char* smem, int li, int u) {
  const int lane = tidx() & 63, w = tidx() >> 6, i = lane & 31, h = lane >> 5;
  const int b = u >> 8, head = (u >> 4) & 15, chunk = u & 15, t0 = chunk * 128 + w * 32, token = t0 + i, ob = t0 >> 8;
  const size_t grow = (size_t)b * S_ + token;
  const bf16_t* qp = (const bf16_t*)(p.ws + O_Q) + grow * 1024 + head * 64 + 32 * h;
  bf16x8 qf[4];
#pragma unroll
  for (int s = 0; s < 4; ++s) qf[s] = *(const bf16x8*)(qp + 8 * s);
  const float* km = (const float*)(p.ws + OFF_KMEAN) + (size_t)li * 65536 + ((size_t)b * 16 + head) * 8 * 64 + 32 * h;
  float gs[7];
#pragma unroll
  for (int j = 0; j < 7; ++j) {
    float a = 0.f;
    if (j < ob) {
#pragma unroll
      for (int s = 0; s < 4; ++s) {
        const float4 k0 = *(const float4*)(km + j * 64 + 8 * s), k1 = *(const float4*)(km + j * 64 + 8 * s + 4);
        union { bf16x8 v; unsigned uu[4]; } t; t.v = qf[s];
        a += bflo(t.uu[0]) * k0.x + bfhi(t.uu[0]) * k0.y + bflo(t.uu[1]) * k0.z + bfhi(t.uu[1]) * k0.w;
        a += bflo(t.uu[2]) * k1.x + bfhi(t.uu[2]) * k1.y + bflo(t.uu[3]) * k1.z + bfhi(t.uu[3]) * k1.w;
      }
      a += __shfl_xor(a, 32);
    }
    gs[j] = a;
  }
  unsigned sel = 0u;
  if (ob <= 3) sel = (1u << ob) - 1u;
  else {
#pragma unroll
    for (int rnd = 0; rnd < 3; ++rnd) {
      float best = NEG_INF; int bi = 0;
#pragma unroll
      for (int j = 0; j < 7; ++j) if (j < ob && !((sel >> j) & 1u) && gs[j] > best) { best = gs[j]; bi = j; }
      sel |= 1u << bi;
    }
  }
  const bf16_t* Kp = (const bf16_t*)(p.ws + O_K) + (size_t)b * S_ * 1024 + head * 64;
  const bf16_t* Vp = (const bf16_t*)(p.ws + O_VT) + (size_t)(b * 16 + head) * 64 * S_;
  Att st; att_init(st, NEG_INF, 0.f);
  MaskMoba mf{sel, token, t0, ob, 8 * h, 0, 0, true};
  att_stream(smem, st, qf, Kp, 1024, Vp, S_, 0, chunk * 2 + 1, lane, mf);
  const float inv = att_invl(st);
#pragma unroll
  for (int r = 0; r < 16; ++r) { st.o0[r] *= inv; st.o1[r] *= inv; }
  store_out(st.o0, st.o1, (const bf16_t*)(p.ws + O_Z) + grow * 1024 + head * 64, (bf16_t*)(p.ws + OFF_H) + grow * 1024 + head * 64, h);
}

enum { PH_P0 = 0, PH_NORM, PH_G1, PH_E3, PH_E4, PH_E5, PH_O3, PH_O4, PH_OUT, PH_FINAL, PH_E4A };

typedef const Params __attribute__((address_space(4))) * KParamPtr;
DI void run_phase(char* smem, int ph, int layer, int vb, int nb) {
#if defined(__HIP_DEVICE_COMPILE__)
  KParamPtr kp = (KParamPtr)__builtin_amdgcn_kernarg_segment_ptr();
  asm volatile("" : "+s"(kp), "+s"(vb), "+s"(nb), "+s"(layer));
  Params p;
  __builtin_memcpy(&p, kp, sizeof(Params));
#else
  Params p{};
#endif
  const int li = layer >> 1;
  switch (ph) {
#if !defined(ONLY) || ONLY == 0
    case PH_P0: phase_p0(p, smem, vb, nb); break;
#endif
#if !defined(ONLY) || ONLY == 1
    case PH_NORM: phase_prep0(p, smem, vb, nb); break;
#endif
#if !defined(ONLY) || ONLY == 2
    case PH_G1: if (layer & 1) phase_g1_odd(p, smem, li, vb, nb); else phase_g1_even(p, smem, li, vb, nb); break;
#endif
#if !defined(ONLY) || ONLY == 3
    case PH_E3:
      if (nb > 256) {
        if (vb < 128) mlp1_tile(p, smem, li, vb);
        else for (int u = vb - 128; u < 1024; u += nb - 128) swa_unit(p, smem, li, u);
      } else {
        for (int u = vb; u < 128 + 1024; u += nb) { if (u < 128) mlp1_tile(p, smem, li, u); else swa_unit(p, smem, li, u - 128); }
      }
      break;
#endif
#if !defined(ONLY) || ONLY == 4
    case PH_E4:
      if (nb > 64) {
        if (vb < 32) mlp2_tile(p, smem, li, vb);
        else {
          const int W = nb - 32, vw = vb - 32;
          for (int r = 0; r * W < 1024; ++r) {
            const int k = r * W + ((r & 1) ? W - 1 - vw : vw);
            if (k < 1024) nsa_win_unit(p, smem, ((k & 15) << 6) | (63 - (k >> 4)));
          }
        }
      } else {
        for (int u = vb; u < 32; u += nb) mlp2_tile(p, smem, li, u);
        for (int k = vb; k < 1024; k += nb) nsa_win_unit(p, smem, ((k & 15) << 6) | (63 - (k >> 4)));
      }
      break;
#endif
#if !defined(ONLY) || ONLY == 5
    case PH_E5:
      for (int r = 0; r * nb < 1024; ++r) {
        const int idx = r * nb + ((r & 1) ? nb - 1 - vb : vb);
        if (idx >= 1024) continue;
        const int tt = 63 - (idx >> 4), bgi = idx & 15;
        nsa_unit(p, smem, (bgi << 6) | tt);
      }
      break;
#endif
#if !defined(ONLY) || ONLY == 6
    case PH_O3: for (int u = vb; u < 512; u += nb) kmean_unit(p, smem, u); break;
#endif
#if !defined(ONLY) || ONLY == 7
    case PH_O4:
      for (int r = 0; r * nb < 2048; ++r) {
        const int idx = r * nb + ((r & 1) ? nb - 1 - vb : vb);
        if (idx >= 2048) continue;
        const int chunk = 15 - (idx >> 7), bh = idx & 127;
        moba_unit(p, smem, li, (bh << 4) | chunk);
      }
      break;
#endif
#if !defined(ONLY) || ONLY == 8
    case PH_OUT: phase_out(p, smem, layer, vb, nb); break;
#endif
#if !defined(ONLY) || ONLY == 9
    case PH_FINAL: phase_final(p, vb, nb); break;
#endif
#if !defined(ONLY) || ONLY == 10
    case PH_E4A: break;
#endif
  }
}

constexpr int SMEM_BYTES = 55296;

template <int PH>
__global__ void __launch_bounds__(256, MINW) phase_kernel(Params p, int layer) {
  __shared__ __attribute__((aligned(16))) char smem[SMEM_BYTES];
  run_phase(smem, PH, layer, blockIdx.x, gridDim.x);
}

#define XB_TMO      128
#define XB_XCNT(j)  (256  + 64 * (j))
#define XB_XSUB(j)  (1280 + 64 * (j))
#define XB_XGEN(j)  (2304 + 64 * (j))
#define XB_TOP      3328
#define XB_TOPGEN   3392
#define XCD_BAR_WORDS 3456
#define XB_SPIN_CAP (1u << 18)
#define LAS __attribute__((address_space(3)))
DI unsigned xb_ld(unsigned* p) { return __hip_atomic_load(p, __ATOMIC_RELAXED, __HIP_MEMORY_SCOPE_AGENT); }
DI unsigned xb_add(unsigned* p, unsigned v) { return __hip_atomic_fetch_add(p, v, __ATOMIC_RELAXED, __HIP_MEMORY_SCOPE_AGENT); }
DI unsigned xb_xcc_id() { return (unsigned)__builtin_amdgcn_s_getreg((3 << 11) | 20) & 0xFu; }
#define XB_SPIN(cond, bar) do { unsigned _sp = 0; while (cond) { __builtin_amdgcn_s_sleep(1); \
    if ((++_sp & 255u) == 0u) { if (xb_ld(&(bar)[XB_TMO])) break; if (_sp > XB_SPIN_CAP) { atomicAdd(&(bar)[XB_TMO], 1u); break; } } } } while (0)
struct XcdBarrier { unsigned* bar; unsigned x; volatile LAS unsigned* st; };
DI XcdBarrier xcd_barrier_post(unsigned* bar, volatile LAS unsigned* st) {
  XcdBarrier b; b.bar = bar; b.x = xb_xcc_id(); b.st = st;
  if (threadIdx.x == 0) (void)xb_add(&bar[XB_XCNT(b.x)], 1u);
  return b;
}
DI void xcd_barrier_complete(unsigned* bar, unsigned x, unsigned& nloc, unsigned& nx) {
  const unsigned G = gridDim.x * gridDim.y * gridDim.z;
  unsigned sum, cnt, mine, sp = 0u;
  for (;;) {
    sum = 0u; cnt = 0u; mine = 0u;
#pragma unroll
    for (unsigned j = 0; j < 16; ++j) { const unsigned c = xb_ld(&bar[XB_XCNT(j)]); sum += c; cnt += (c > 0u) ? 1u : 0u; mine = (j == x) ? c : mine; }
    if (sum == G) break;
    __builtin_amdgcn_s_sleep(1);
    if ((++sp & 255u) == 0u) { if (xb_ld(&bar[XB_TMO])) break; if (sp > XB_SPIN_CAP) { atomicAdd(&bar[XB_TMO], 1u); break; } }
  }
  nloc = mine > 0u ? mine : 1u; nx = cnt > 0u ? cnt : 1u;
}
DI void xcd_barrier(const XcdBarrier& b) {
  asm volatile("s_waitcnt vmcnt(0)" ::: "memory");
  __syncthreads();
  if (threadIdx.x == 0) {
    unsigned* bar = b.bar;
    __builtin_amdgcn_s_waitcnt(0);
    unsigned nloc = b.st[0], nx = b.st[1];
    if (nloc == 0u) { xcd_barrier_complete(bar, b.x, nloc, nx); b.st[0] = nloc; b.st[1] = nx; }
    const unsigned old = xb_add(&bar[XB_XSUB(b.x)], 1u);
    const unsigned gen = old / nloc;
    if (old + 1u == (gen + 1u) * nloc) {
      __builtin_amdgcn_fence(__ATOMIC_RELEASE, "agent");
      asm volatile("s_waitcnt vmcnt(0)" ::: "memory");
      const unsigned og = xb_add(&bar[XB_TOP], 1u);
      const unsigned tg = og / nx;
      if (og + 1u == (tg + 1u) * nx) xb_add(&bar[XB_TOPGEN], 1u);
      else XB_SPIN(xb_ld(&bar[XB_TOPGEN]) == tg, bar);
      __builtin_amdgcn_fence(__ATOMIC_ACQUIRE, "agent");
      xb_add(&bar[XB_XGEN(b.x)], 1u);
      asm volatile("s_waitcnt vmcnt(0)" ::: "memory");
    } else {
      XB_SPIN(xb_ld(&bar[XB_XGEN(b.x)]) == gen, bar);
      __builtin_amdgcn_fence(__ATOMIC_ACQUIRE, "agent");
      asm volatile("s_waitcnt vmcnt(0)" ::: "memory");
    }
  }
  __syncthreads();
}

__global__ void __launch_bounds__(256, MINW) mega_kernel(Params p) {
  __shared__ __attribute__((aligned(16))) char smem[SMEM_BYTES];
  cg::grid_group grid = cg::this_grid();
  const int vb = blockIdx.x, nb = gridDim.x;
  __shared__ uint4 xb_words;
  unsigned* bar = (unsigned*)(p.ws + OFF_BAR);
  if (threadIdx.x == 0) xb_words = make_uint4(0u, 0u, 0u, 0u);
  if (vb == 0) for (int k = threadIdx.x; k < XCD_BAR_WORDS; k += 256) __hip_atomic_store(bar + k, 0u, __ATOMIC_RELAXED, __HIP_MEMORY_SCOPE_AGENT);
  __syncthreads();
  run_phase(smem, PH_P0, 0, vb, nb);
  if (PROBE_DUP & 2048) { __syncthreads(); run_phase(smem, PH_P0, 0, vb, nb); }
  grid.sync();
  const XcdBarrier xb = xcd_barrier_post(bar, (volatile LAS unsigned*)&xb_words);
#define GSYNC() xcd_barrier(xb)
  for (int layer = 0; layer < 4; ++layer) {
    if (layer == 0) { run_phase(smem, PH_NORM, layer, vb, nb); GSYNC(); if (PROBE_DUP & 4096) { run_phase(smem, PH_NORM, layer, vb, nb); GSYNC(); } }
    run_phase(smem, PH_G1, layer, vb, nb); GSYNC();
    if (PROBE_DUP & 1) { run_phase(smem, PH_G1, layer, vb, nb); GSYNC(); }
    if (layer & 1) {
      run_phase(smem, PH_O4, layer, vb, nb); GSYNC();
      if (PROBE_DUP & 4) { run_phase(smem, PH_O4, layer, vb, nb); GSYNC(); }
    } else {
      run_phase(smem, PH_E3, layer, vb, nb); GSYNC();
      if (PROBE_DUP & 8) { run_phase(smem, PH_E3, layer, vb, nb); GSYNC(); }
      run_phase(smem, PH_E4, layer, vb, nb); GSYNC();
      run_phase(smem, PH_E5, layer, vb, nb); GSYNC();
      if (PROBE_DUP & 2) { run_phase(smem, PH_E5, layer, vb, nb); GSYNC(); }
    }
    run_phase(smem, PH_OUT, layer, vb, nb); GSYNC();
    if ((PROBE_DUP & 32) && layer == 0) { for (int k = 0; k < 4; ++k) { run_phase(smem, PH_OUT, layer, vb, nb); GSYNC(); } }
  }
  if (PROBE_DUP & 64) { run_phase(smem, PH_P0, 0, vb, nb); GSYNC(); }
  if (PROBE_DUP & 128) { for (int k = 0; k < 20; ++k) GSYNC(); }
  if (PROBE_DUP & 256) { for (int k = 0; k < 4; ++k) { run_phase(smem, PH_O3, 1, vb, nb); GSYNC(); } }
#undef GSYNC
  run_phase(smem, PH_FINAL, 0, vb, nb);
}

extern "C" void kernel_launch(void* const* d_in, const int* in_sizes, int n_in, void* d_out, int out_size, void* d_ws, size_t ws_size,
                              hipStream_t stream) {
  Params p{};
  p.x = (const float*)d_in[0]; p.c = (const float*)d_in[1]; p.w_ada = (const float*)d_in[2]; p.b_ada = (const float*)d_in[3];
  p.norm_g = (const float*)d_in[4]; p.w_in_even = (const float*)d_in[5]; p.a_sinks = (const float*)d_in[6];
  p.pe_k = (const float*)d_in[7]; p.w1k = (const float*)d_in[8]; p.w2k = (const float*)d_in[9];
  p.pe_v = (const float*)d_in[10]; p.w1v = (const float*)d_in[11]; p.w2v = (const float*)d_in[12];
  p.w_out_even = (const float*)d_in[13]; p.w_in_odd = (const float*)d_in[14]; p.w_out_odd = (const float*)d_in[15];
  p.final_g = (const float*)d_in[16];
  p.out = (float*)d_out; p.ws = (char*)d_ws;
#if FUSED
  static int grid_blocks = 0;
  if (!grid_blocks) {
    int dev = 0, cus = 0, per_cu = 0;
    hipGetDevice(&dev);
    hipDeviceGetAttribute(&cus, hipDeviceAttributeMultiprocessorCount, dev);
    hipOccupancyMaxActiveBlocksPerMultiprocessor(&per_cu, mega_kernel, 256, 0);
    if (per_cu > 2) per_cu = 2;
    if (per_cu < 1) per_cu = 1;
    grid_blocks = cus * per_cu;
  }
  void* args[] = {&p};
  hipError_t e = hipLaunchCooperativeKernel((void*)mega_kernel, dim3(grid_blocks), dim3(256), args, 0, stream);
  if (e != hipSuccess) fprintf(stderr, "cooperative launch failed: %s (grid %d)\n", hipGetErrorString(e), grid_blocks);
#else
  const int G = 1024;
#define L(PH, layer) phase_kernel<PH><<<G, 256, 0, stream>>>(p, layer)
  L(PH_P0, 0);
  for (int layer = 0; layer < 4; ++layer) {
    if (layer == 0) L(PH_NORM, layer);
    L(PH_G1, layer); if (PROBE_DUP & 1) L(PH_G1, layer);
    if (layer & 1) { L(PH_O4, layer); if (PROBE_DUP & 4) L(PH_O4, layer); }
    else { L(PH_E3, layer); if (PROBE_DUP & 8) L(PH_E3, layer); L(PH_E4, layer); L(PH_E5, layer); if (PROBE_DUP & 2) L(PH_E5, layer); }
    L(PH_OUT, layer);
  }
  L(PH_FINAL, 0);
#undef L
#endif
}
```

```cpp
#include <hip/hip_runtime.h>
#include <hip/hip_cooperative_groups.h>
#include <stdint.h>
#include <stdio.h>
namespace cg = cooperative_groups;

#ifndef FUSED
#define FUSED 1
#endif
#ifndef PROBE_DUP
#define PROBE_DUP 0
#endif
#ifndef MINW
#define MINW 2
#endif

typedef unsigned short bf16_t;
typedef short bf16x8 __attribute__((ext_vector_type(8)));
typedef float f32x16 __attribute__((ext_vector_type(16)));
typedef unsigned u32x4 __attribute__((ext_vector_type(4)));
typedef unsigned u32x2 __attribute__((ext_vector_type(2)));
typedef float f32x4 __attribute__((ext_vector_type(4)));
#define DI __device__ __forceinline__
#define MFMA(a, b, c) __builtin_amdgcn_mfma_f32_32x32x16_bf16((a), (b), (c), 0, 0, 0)
#define NEG_INF (-__builtin_inff())

constexpr int S_ = 2048, T_ = 16384;
constexpr float SC2 = 0.125f * 1.44269504088896f;
constexpr float LOG2E = 1.44269504088896f;

constexpr size_t MBy = 1u << 20;
constexpr size_t OFF_H = 0;
constexpr size_t OFF_PROJ = 32 * MBy;
constexpr size_t OFF_WIE = 160 * MBy;
constexpr size_t OFF_WIO = 172 * MBy;
constexpr size_t OFF_WOE = 188 * MBy;
constexpr size_t OFF_WOO = 192 * MBy;
constexpr size_t OFF_W1 = 196 * MBy;
constexpr size_t OFF_W2 = 200 * MBy;
constexpr size_t OFF_ADA = 201 * MBy;
constexpr size_t OFF_ROPE = 204 * MBy;
constexpr size_t OFF_PEB = 205 * MBy;
constexpr size_t OFF_HID = 206 * MBy;
constexpr size_t OFF_KCMP = 208 * MBy;
constexpr size_t OFF_VCMPT = 208 * MBy + 512 * 1024;
constexpr size_t OFF_KMEAN = 209 * MBy;
constexpr size_t OFF_BAR = 210 * MBy;
constexpr size_t OFF_A2 = 212 * MBy;
constexpr size_t OFF_ROWSS = 245 * MBy;
constexpr size_t OFF_GG = 246 * MBy;
constexpr size_t OFF_BIAS = 247 * MBy;
constexpr size_t OFF_OWIN = OFF_PROJ + 112 * MBy;
constexpr size_t OFF_PART = OFF_PROJ + 96 * MBy;
constexpr size_t OFF_PEBF = OFF_PEB + 512 * 1024;
constexpr size_t E_QA = OFF_PROJ, E_ZA = OFF_PROJ + 16 * MBy, E_QB = OFF_PROJ + 32 * MBy, E_ZB = OFF_PROJ + 48 * MBy;
constexpr size_t E_KA = OFF_PROJ + 64 * MBy, E_VAT = OFF_PROJ + 66 * MBy, E_KC = OFF_PROJ + 68 * MBy, E_VC = OFF_PROJ + 72 * MBy;
constexpr size_t E_KS = OFF_PROJ + 76 * MBy, E_VST = OFF_PROJ + 80 * MBy, E_KW = OFF_PROJ + 84 * MBy, E_VWT = OFF_PROJ + 88 * MBy;
constexpr size_t E_GB = OFF_PROJ + 92 * MBy;
constexpr size_t O_Q = OFF_PROJ, O_K = OFF_PROJ + 32 * MBy, O_VT = OFF_PROJ + 64 * MBy, O_Z = OFF_PROJ + 96 * MBy;

struct Params {
  const float *x, *c, *w_ada, *b_ada, *norm_g, *w_in_even, *a_sinks, *pe_k, *w1k, *w2k, *pe_v, *w1v, *w2v, *w_out_even, *w_in_odd, *w_out_odd, *final_g;
  float* out;
  char* ws;
};

typedef __bf16 bf16v2 __attribute__((ext_vector_type(2)));
DI unsigned pk2(float lo, float hi) { bf16v2 v = {(__bf16)lo, (__bf16)hi}; return __builtin_bit_cast(unsigned, v); }
DI unsigned f2bf(float x) { return pk2(x, 0.f) & 0xffffu; }
DI float bf2f(unsigned b) { return __uint_as_float(b << 16); }
DI float bflo(unsigned u) { return __uint_as_float(u << 16); }
DI float bfhi(unsigned u) { return __uint_as_float(u & 0xffff0000u); }
DI int tidx() { int t = (int)__builtin_amdgcn_workitem_id_x(); asm volatile("" : "+v"(t)); return t; }
DI int crow(int r, int h) { return (r & 3) + 8 * (r >> 2) + 4 * h; }
DI float siluf(float z) { return z / (1.f + __expf(-z)); }
DI float ex2(float x) { return __builtin_amdgcn_exp2f(x); }

template <class ARow, class Epi>
DI void gemm_tiles(char* smem, const bf16_t* __restrict__ A, ARow arow, const bf16_t* __restrict__ Wt, int ldb, int K, int MT, int NT,
                   int vb, int nb, Epi epi, bool xcd_order = false) {
  bf16_t* As = (bf16_t*)smem;
  bf16_t* Bs = As + 128 * 72;
  const int tid = tidx(), lane = tid & 63, w = tid >> 6, wm = w >> 1, wn = w & 1;
  const int lr = tid >> 3, lc = (tid & 7) * 8;
  const int KT = K >> 6;
  const int i = lane & 31, h = lane >> 5;
  const bool xo = xcd_order && ((nb & 7) == 0) && ((MT & 7) == 0);
  const int t_start = xo ? (vb >> 3) : vb, t_step = xo ? (nb >> 3) : nb, t_total = xo ? (MT >> 3) * NT : MT * NT;
  for (int tile = t_start; tile < t_total; tile += t_step) {
    int tm, tn;
    if (xo) { const int gsz = 8 * NT, gid = tile / gsz, wi = tile - gid * gsz; tm = (vb & 7) * (MT >> 3) + gid * 8 + (wi & 7); tn = wi >> 3; }
    else { tm = tile / NT; tn = tile - tm * NT; }
    const bf16_t* ap0 = A + arow(tm * 128 + lr) + lc;
    const size_t astep = arow(tm * 128 + 32 + lr) - arow(tm * 128 + lr);
    const bf16_t* bp = Wt + (size_t)(tn * 256 + lr) * ldb + lc;
    const size_t bstep = (size_t)32 * ldb;
    u32x4 ra0, ra1, ra2, ra3, rb0, rb1, rb2, rb3, rb4, rb5, rb6, rb7;
#define GLOAD(ko)                                                                                         \
    ra0 = *(const u32x4*)(ap0 + (ko)); ra1 = *(const u32x4*)(ap0 + astep + (ko));                         \
    ra2 = *(const u32x4*)(ap0 + 2 * astep + (ko)); ra3 = *(const u32x4*)(ap0 + 3 * astep + (ko));         \
    rb0 = *(const u32x4*)(bp + (ko)); rb1 = *(const u32x4*)(bp + bstep + (ko));                           \
    rb2 = *(const u32x4*)(bp + 2 * bstep + (ko)); rb3 = *(const u32x4*)(bp + 3 * bstep + (ko));           \
    rb4 = *(const u32x4*)(bp + 4 * bstep + (ko)); rb5 = *(const u32x4*)(bp + 5 * bstep + (ko));           \
    rb6 = *(const u32x4*)(bp + 6 * bstep + (ko)); rb7 = *(const u32x4*)(bp + 7 * bstep + (ko));
    GLOAD(0)
    f32x16 acc[2][2][2];
#pragma unroll
    for (int a = 0; a < 2; ++a)
#pragma unroll
      for (int b = 0; b < 2; ++b)
#pragma unroll
        for (int c = 0; c < 2; ++c)
#pragma unroll
          for (int r = 0; r < 16; ++r) acc[a][b][c][r] = 0.f;
    for (int kt = 0; kt < KT; ++kt) {
      __syncthreads();
      *(u32x4*)(As + (lr) * 72 + lc) = ra0; *(u32x4*)(As + (32 + lr) * 72 + lc) = ra1;
      *(u32x4*)(As + (64 + lr) * 72 + lc) = ra2; *(u32x4*)(As + (96 + lr) * 72 + lc) = ra3;
      *(u32x4*)(Bs + (lr) * 72 + lc) = rb0; *(u32x4*)(Bs + (32 + lr) * 72 + lc) = rb1;
      *(u32x4*)(Bs + (64 + lr) * 72 + lc) = rb2; *(u32x4*)(Bs + (96 + lr) * 72 + lc) = rb3;
      *(u32x4*)(Bs + (128 + lr) * 72 + lc) = rb4; *(u32x4*)(Bs + (160 + lr) * 72 + lc) = rb5;
      *(u32x4*)(Bs + (192 + lr) * 72 + lc) = rb6; *(u32x4*)(Bs + (224 + lr) * 72 + lc) = rb7;
      __syncthreads();
      if (kt + 1 < KT) { const int ko = (kt + 1) * 64; GLOAD(ko) }
#pragma unroll
      for (int s = 0; s < 4; ++s) {
        bf16x8 af[2];
#pragma unroll
        for (int mi = 0; mi < 2; ++mi) af[mi] = *(const bf16x8*)(As + (wm * 64 + mi * 32 + i) * 72 + s * 16 + h * 8);
#pragma unroll
        for (int hf = 0; hf < 2; ++hf) {
          bf16x8 bfr[2];
#pragma unroll
          for (int ni = 0; ni < 2; ++ni) bfr[ni] = *(const bf16x8*)(Bs + (wn * 128 + hf * 64 + ni * 32 + i) * 72 + s * 16 + h * 8);
#pragma unroll
          for (int ni = 0; ni < 2; ++ni)
#pragma unroll
            for (int mi = 0; mi < 2; ++mi) acc[hf][mi][ni] = MFMA(bfr[ni], af[mi], acc[hf][mi][ni]);
        }
      }
    }
#undef GLOAD
    __syncthreads();
    epi(acc[0], tm * 128 + wm * 64, tn * 256 + wn * 128, lane, smem + w * 9216);
    epi(acc[1], tm * 128 + wm * 64, tn * 256 + wn * 128 + 64, lane, smem + w * 9216);
  }
}

DI void stage_flush(const bf16_t* img, bf16_t* dst, int ld, int lane) {
  asm volatile("" ::: "memory");
  const bf16_t* ip = img + (lane >> 3) * 72 + (lane & 7) * 8;
  bf16_t* dp = dst + (size_t)(lane >> 3) * ld + (lane & 7) * 8;
#pragma unroll
  for (int ps = 0; ps < 8; ++ps) {
    const u32x4 q = *(const u32x4*)(ip + ps * 8 * 72);
    *(u32x4*)dp = q;
    dp += 8 * ld;
  }
}
DI void st_rm(const f32x16 (&acc)[2][2], char* wsm, bf16_t* dst, int ld, int lane) {
  bf16_t* img = (bf16_t*)wsm;
  bf16_t* lp = img + (lane & 31) * 72 + 4 * (lane >> 5);
#pragma unroll
  for (int mi = 0; mi < 2; ++mi)
#pragma unroll
    for (int ni = 0; ni < 2; ++ni)
#pragma unroll
      for (int a = 0; a < 4; ++a) {
        uint2 o; o.x = pk2(acc[mi][ni][4 * a], acc[mi][ni][4 * a + 1]); o.y = pk2(acc[mi][ni][4 * a + 2], acc[mi][ni][4 * a + 3]);
        *(uint2*)(lp + (32 * mi * 72 + 32 * ni + 8 * a)) = o;
      }
  stage_flush(img, dst, ld, lane);
}
DI void st_rm_rope(const f32x16 (&acc)[2][2], char* wsm, bf16_t* dst, int ld, int lane, const float* cosT, const float* sinT, int pos0) {
  bf16_t* img = (bf16_t*)wsm;
  const int t = lane & 31, h = lane >> 5;
  bf16_t* lp = img + t * 72 + 4 * h;
  const float* cp = cosT + (pos0 + t) * 32 + 4 * h;
  const float* sp = sinT + (pos0 + t) * 32 + 4 * h;
#pragma unroll
  for (int mi = 0; mi < 2; ++mi)
#pragma unroll
    for (int a = 0; a < 4; ++a) {
      const float4 cs = *(const float4*)(cp + (32 * mi * 32 + 8 * a));
      const float4 sn = *(const float4*)(sp + (32 * mi * 32 + 8 * a));
      const float x10 = acc[mi][0][4 * a], x11 = acc[mi][0][4 * a + 1], x12 = acc[mi][0][4 * a + 2], x13 = acc[mi][0][4 * a + 3];
      const float x20 = acc[mi][1][4 * a], x21 = acc[mi][1][4 * a + 1], x22 = acc[mi][1][4 * a + 2], x23 = acc[mi][1][4 * a + 3];
      uint2 o1, o2;
      o1.x = pk2(x10 * cs.x - x20 * sn.x, x11 * cs.y - x21 * sn.y); o1.y = pk2(x12 * cs.z - x22 * sn.z, x13 * cs.w - x23 * sn.w);
      o2.x = pk2(x20 * cs.x + x10 * sn.x, x21 * cs.y + x11 * sn.y); o2.y = pk2(x22 * cs.z + x12 * sn.z, x23 * cs.w + x13 * sn.w);
      *(uint2*)(lp + (32 * mi * 72 + 8 * a)) = o1;
      *(uint2*)(lp + (32 * mi * 72 + 32 + 8 * a)) = o2;
    }
  stage_flush(img, dst, ld, lane);
}
DI void st_tr(const f32x16 (&acc)[2][2], char* wsm, bf16_t* dst, int ld, int lane, int ztok) {
  bf16_t* img = (bf16_t*)wsm;
  const int t = lane & 31, h = lane >> 5;
  bf16_t* lp = img + 4 * h * 72 + t;
#pragma unroll
  for (int mi = 0; mi < 2; ++mi) {
    const bool z = (32 * mi + t) == ztok;
#pragma unroll
    for (int ni = 0; ni < 2; ++ni)
#pragma unroll
      for (int r = 0; r < 16; ++r) {
        const float v = z ? 0.f : acc[mi][ni][r];
        lp[(32 * ni + (r & 3) + 8 * (r >> 2)) * 72 + 32 * mi] = (bf16_t)f2bf(v);
      }
  }
  stage_flush(img, dst, ld, lane);
}

DI f32x16 qk_scores(const bf16x8 (&qf)[4], const bf16_t* __restrict__ Kp, int kstride, int key0, int lane) {
  const int i = lane & 31, h = lane >> 5;
  const int a = i >> 3, hh = (i >> 2) & 1, b = i & 3;
  const int kperm = 16 * (a >> 1) + 8 * hh + 4 * (a & 1) + b;
  const bf16_t* kr = Kp + (size_t)(key0 + kperm) * kstride + 32 * h;
  bf16x8 kf[4];
#pragma unroll
  for (int s = 0; s < 4; ++s) kf[s] = *(const bf16x8*)(kr + 8 * s);
  f32x16 sa;
#pragma unroll
  for (int r = 0; r < 16; ++r) sa[r] = 0.f;
#pragma unroll
  for (int s = 0; s < 4; ++s) sa = MFMA(kf[s], qf[s], sa);
  return sa;
}
DI void load_kf(bf16x8 (&kf)[4], const bf16_t* __restrict__ Kp, int kstride, int key0, int lane) {
  const int i = lane & 31, h = lane >> 5;
  const int a = i >> 3, hh = (i >> 2) & 1, b = i & 3;
  const int kperm = 16 * (a >> 1) + 8 * hh + 4 * (a & 1) + b;
  const bf16_t* kr = Kp + (size_t)(key0 + kperm) * kstride + 32 * h;
#pragma unroll
  for (int s = 0; s < 4; ++s) kf[s] = *(const bf16x8*)(kr + 8 * s);
}
DI f32x16 qk_mfma(const bf16x8 (&kf)[4], const bf16x8 (&qf)[4]) {
  f32x16 sa;
#pragma unroll
  for (int r = 0; r < 16; ++r) sa[r] = 0.f;
#pragma unroll
  for (int s = 0; s < 4; ++s) sa = MFMA(kf[s], qf[s], sa);
  return sa;
}
DI void load_v(bf16x8 (&vf)[2][2], const bf16_t* __restrict__ Vp, int vstride, int key0, int lane) {
  const int i = lane & 31, h = lane >> 5;
#pragma unroll
  for (int dt = 0; dt < 2; ++dt)
#pragma unroll
    for (int s2 = 0; s2 < 2; ++s2) vf[dt][s2] = *(const bf16x8*)(Vp + (size_t)(32 * dt + i) * vstride + key0 + 16 * s2 + 8 * h);
}
DI void pack_p(const float (&p)[16], bf16x8 (&pf)[2]) {
#pragma unroll
  for (int s2 = 0; s2 < 2; ++s2) {
    union { bf16x8 v; unsigned u[4]; } t;
#pragma unroll
    for (int j = 0; j < 4; ++j) t.u[j] = pk2(p[8 * s2 + 2 * j], p[8 * s2 + 2 * j + 1]);
    pf[s2] = t.v;
  }
}
struct Att { float m, l; f32x16 o0, o1; };
DI void att_init(Att& st, float m0, float l0) {
  st.m = m0; st.l = l0;
#pragma unroll
  for (int r = 0; r < 16; ++r) { st.o0[r] = 0.f; st.o1[r] = 0.f; }
}
template <class MaskF>
DI void att_tile(Att& st, const bf16x8 (&qf)[4], const bf16_t* __restrict__ Kp, int kstride, const bf16_t* __restrict__ Vp, int vstride,
                 int key0, int lane, MaskF mask) {
  const int h = lane >> 5;
  f32x16 sa = qk_scores(qf, Kp, kstride, key0, lane);
  bf16x8 vf[2][2];
  load_v(vf, Vp, vstride, key0, lane);
  float p[16];
  float mx = NEG_INF;
#pragma unroll
  for (int r = 0; r < 16; ++r) {
    const int key = key0 + 16 * (r >> 3) + 8 * h + (r & 7);
    const float v = mask(key) ? sa[r] * SC2 : NEG_INF;
    p[r] = v; mx = fmaxf(mx, v);
  }
  mx = fmaxf(mx, __shfl_xor(mx, 32));
  const float mnew = fmaxf(st.m, mx);
  const float msafe = (mnew == NEG_INF) ? 0.f : mnew;
  const float alpha = ex2(st.m - msafe);
  float sum = 0.f;
#pragma unroll
  for (int r = 0; r < 16; ++r) { const float e = ex2(p[r] - msafe); p[r] = e; sum += e; }
  st.l = st.l * alpha + sum; st.m = mnew;
#pragma unroll
  for (int r = 0; r < 16; ++r) { st.o0[r] *= alpha; st.o1[r] *= alpha; }
  bf16x8 pf[2];
  pack_p(p, pf);
#pragma unroll
  for (int s2 = 0; s2 < 2; ++s2) { st.o0 = MFMA(vf[0][s2], pf[s2], st.o0); st.o1 = MFMA(vf[1][s2], pf[s2], st.o1); }
}
DI float att_invl(const Att& st) { const float l = st.l + __shfl_xor(st.l, 32); return l > 0.f ? 1.f / l : 0.f; }
DI void store_out(const f32x16& o0, const f32x16& o1, const bf16_t* __restrict__ zrow, bf16_t* __restrict__ orow, int h) {
  uint2 zz[8];
#pragma unroll
  for (int k = 0; k < 8; ++k) zz[k] = *(const uint2*)(zrow + 32 * (k >> 2) + 8 * (k & 3) + 4 * h);
#pragma unroll
  for (int dt = 0; dt < 2; ++dt)
#pragma unroll
    for (int a = 0; a < 4; ++a) {
      const int d = 32 * dt + 8 * a + 4 * h;
      const uint2 z2 = zz[dt * 4 + a];
      const f32x16& o = dt ? o1 : o0;
      const float r0 = o[4 * a] * siluf(bflo(z2.x)), r1 = o[4 * a + 1] * siluf(bfhi(z2.x));
      const float r2 = o[4 * a + 2] * siluf(bflo(z2.y)), r3 = o[4 * a + 3] * siluf(bfhi(z2.y));
      uint2 ov; ov.x = pk2(r0, r1); ov.y = pk2(r2, r3);
      *(uint2*)(orow + d) = ov;
    }
}

struct TrTile { const float* src; bf16_t* dst; int ldn, src_col0, nvalid, k0, ldk, n0; };
DI void transpose_pair(char* smem, const TrTile& a, const TrTile& b, bool two) {
  float* ta = (float*)smem;
  float* tb = ta + 64 * 65 + 16;
  const int tid = tidx();
  const int kr0 = tid >> 4, c4 = (tid & 15) * 4;
  float4 va[4], vb4[4];
#pragma unroll
  for (int p = 0; p < 4; ++p) {
    va[p] = make_float4(0.f, 0.f, 0.f, 0.f); vb4[p] = make_float4(0.f, 0.f, 0.f, 0.f);
    if (c4 < a.nvalid) va[p] = *(const float4*)(a.src + (size_t)(a.k0 + kr0 + 16 * p) * a.ldn + a.src_col0 + c4);
    if (two && c4 < b.nvalid) vb4[p] = *(const float4*)(b.src + (size_t)(b.k0 + kr0 + 16 * p) * b.ldn + b.src_col0 + c4);
  }
  __syncthreads();
#pragma unroll
  for (int p = 0; p < 4; ++p) {
    const int kr = kr0 + 16 * p;
    ta[kr * 65 + c4] = va[p].x; ta[kr * 65 + c4 + 1] = va[p].y; ta[kr * 65 + c4 + 2] = va[p].z; ta[kr * 65 + c4 + 3] = va[p].w;
    tb[kr * 65 + c4] = vb4[p].x; tb[kr * 65 + c4 + 1] = vb4[p].y; tb[kr * 65 + c4 + 2] = vb4[p].z; tb[kr * 65 + c4 + 3] = vb4[p].w;
  }
  __syncthreads();
  const int n = tid >> 2, ks = (tid & 3) * 16;
  {
    unsigned o[8];
#pragma unroll
    for (int j = 0; j < 8; ++j) o[j] = pk2(ta[(ks + 2 * j) * 65 + n], ta[(ks + 2 * j + 1) * 65 + n]);
    uint4* dp = (uint4*)(a.dst + (size_t)(a.n0 + n) * a.ldk + a.k0 + ks);
    dp[0] = make_uint4(o[0], o[1], o[2], o[3]);
    dp[1] = make_uint4(o[4], o[5], o[6], o[7]);
  }
  if (two) {
    unsigned o[8];
#pragma unroll
    for (int j = 0; j < 8; ++j) o[j] = pk2(tb[(ks + 2 * j) * 65 + n], tb[(ks + 2 * j + 1) * 65 + n]);
    uint4* dp = (uint4*)(b.dst + (size_t)(b.n0 + n) * b.ldk + b.k0 + ks);
    dp[0] = make_uint4(o[0], o[1], o[2], o[3]);
    dp[1] = make_uint4(o[4], o[5], o[6], o[7]);
  }
}
DI TrTile tr_tile(const Params& p, int t) {
  constexpr int T1 = 2 * 48 * 16, T2 = 2 * 64 * 16, T3 = 2 * 16 * 16, T4 = 2 * 16 * 16, T5 = 4 * 4 * 32;
  TrTile r;
  if (t < T1) {
    const int layer = t / 768, q = t % 768, nt = q >> 4, kt = q & 15;
    int src0, nvalid = 64;
    if (nt < 38) src0 = nt * 64; else if (nt < 46) src0 = 2456 + (nt - 38) * 64; else if (nt == 46) { src0 = 2432; nvalid = 24; } else { src0 = 0; nvalid = 0; }
    r.src = p.w_in_even + (size_t)layer * 1024 * 2968; r.ldn = 2968; r.src_col0 = src0; r.nvalid = nvalid; r.k0 = kt * 64;
    r.dst = (bf16_t*)(p.ws + OFF_WIE) + (size_t)layer * 3072 * 1024; r.ldk = 1024; r.n0 = nt * 64;
  } else if ((t -= T1) < T2) {
    const int layer = t / 1024, q = t % 1024, nt = q >> 4, kt = q & 15;
    r.src = p.w_in_odd + (size_t)layer * 1024 * 4096; r.ldn = 4096; r.src_col0 = nt * 64; r.nvalid = 64; r.k0 = kt * 64;
    r.dst = (bf16_t*)(p.ws + OFF_WIO) + (size_t)layer * 4096 * 1024; r.ldk = 1024; r.n0 = nt * 64;
  } else if ((t -= T2) < T3) {
    const int layer = t / 256, q = t % 256, nt = q >> 4, kt = q & 15;
    r.src = p.w_out_even + (size_t)layer * 1024 * 1024; r.ldn = 1024; r.src_col0 = nt * 64; r.nvalid = 64; r.k0 = kt * 64;
    r.dst = (bf16_t*)(p.ws + OFF_WOE) + (size_t)layer * 1024 * 1024; r.ldk = 1024; r.n0 = nt * 64;
  } else if ((t -= T3) < T4) {
    const int layer = t / 256, q = t % 256, nt = q >> 4, kt = q & 15;
    r.src = p.w_out_odd + (size_t)layer * 1024 * 1024; r.ldn = 1024; r.src_col0 = nt * 64; r.nvalid = 64; r.k0 = kt * 64;
    r.dst = (bf16_t*)(p.ws + OFF_WOO) + (size_t)layer * 1024 * 1024; r.ldk = 1024; r.n0 = nt * 64;
  } else if ((t -= T4) < T5) {
    const int lk = t / 128, q = t % 128, nt = q >> 5, kt = q & 31, layer = lk >> 1, kv = lk & 1;
    r.src = (kv ? p.w1v : p.w1k) + (size_t)layer * 2048 * 256; r.ldn = 256; r.src_col0 = nt * 64; r.nvalid = 64; r.k0 = kt * 64;
    r.dst = (bf16_t*)(p.ws + OFF_W1) + (size_t)lk * 256 * 2048; r.ldk = 2048; r.n0 = nt * 64;
  } else {
    t -= T5;
    const int lk = t / 16, q = t % 16, nt = q >> 2, kt = q & 3, layer = lk >> 1, kv = lk & 1;
    r.src = (kv ? p.w2v : p.w2k) + (size_t)layer * 256 * 64; r.ldn = 64; r.src_col0 = 0; r.nvalid = nt ? 0 : 64; r.k0 = kt * 64;
    r.dst = (bf16_t*)(p.ws + OFF_W2) + (size_t)lk * 256 * 256; r.ldk = 256; r.n0 = nt * 64;
  }
  return r;
}

DI void phase_p0(const Params& p, char* smem, int vb, int nb) {
  const int tid = tidx(), lane = tid & 63, w = tid >> 6;
  constexpr int N_ADA = 192, N_PEB = 64, N_ROPE = 256;
  constexpr int U0 = N_ADA + N_PEB + N_ROPE;
  constexpr int T1 = 2 * 48 * 16, T2 = 2 * 64 * 16, T3 = 2 * 16 * 16, T4 = 2 * 16 * 16, T5 = 4 * 4 * 32, T6 = 4 * 4 * 4;
  constexpr int NU = U0 + T1 + T2 + T3 + T4 + T5 + T6;
  for (int k = vb * 256 + tid; k < 4 * T_; k += nb * 256) ((float*)(p.ws + OFF_ROWSS))[T_ + k] = 0.f;
  for (int k = vb * 256 + tid; k < 2 * 65536; k += nb * 256) ((float*)(p.ws + OFF_KMEAN))[k] = 0.f;
  for (int u = vb; u < U0; u += nb) {
    if (u < N_ADA) {
      float* sc = (float*)smem;
      __syncthreads();
      for (int k = tid; k < 8192; k += 256) sc[k] = siluf(p.c[k]);
      __syncthreads();
      const int l = u / 48, eg = u % 48, e = eg * 64 + lane;
      float acc[8];
#pragma unroll
      for (int b = 0; b < 8; ++b) acc[b] = 0.f;
      const float* wp = p.w_ada + (size_t)l * 1024 * 3072 + e;
#pragma unroll 8
      for (int d0 = w * 256; d0 < w * 256 + 256; d0 += 4) {
        const float w0 = wp[(size_t)d0 * 3072], w1 = wp[(size_t)(d0 + 1) * 3072], w2 = wp[(size_t)(d0 + 2) * 3072], w3 = wp[(size_t)(d0 + 3) * 3072];
#pragma unroll
        for (int b = 0; b < 8; ++b) {
          const float4 cv = *(const float4*)(sc + b * 1024 + d0);
          acc[b] += cv.x * w0 + cv.y * w1 + cv.z * w2 + cv.w * w3;
        }
      }
      __syncthreads();
      float* red = (float*)smem;
#pragma unroll
      for (int b = 0; b < 8; ++b) red[(w * 8 + b) * 64 + lane] = acc[b];
      __syncthreads();
      for (int k = tid; k < 512; k += 256) {
        const int b = k >> 6, ln = k & 63;
        const float v = red[(0 * 8 + b) * 64 + ln] + red[(1 * 8 + b) * 64 + ln] + red[(2 * 8 + b) * 64 + ln] + red[(3 * 8 + b) * 64 + ln];
        const int ee = eg * 64 + ln;
        ((float*)(p.ws + OFF_ADA))[(size_t)(l * 8 + b) * 3072 + ee] = v + p.b_ada[l * 3072 + ee];
      }
    } else if (u < N_ADA + N_PEB) {
      const int uu = u - N_ADA, lk = uu >> 4, ch = uu & 15, layer = lk >> 1, kv = lk & 1;
      const float* pe = (kv ? p.pe_v : p.pe_k) + layer * 2048;
      const float* w1 = (kv ? p.w1v : p.w1k) + (size_t)layer * 2048 * 256;
      float acc = 0.f;
#pragma unroll 16
      for (int k = ch * 128; k < ch * 128 + 128; ++k) acc += pe[k] * w1[(size_t)k * 256 + tid];
      ((float*)(p.ws + OFF_PEB))[(lk * 16 + ch) * 256 + tid] = acc;
    } else if (u < U0) {
      const int idx = (u - N_ADA - N_PEB) * 256 + tid, pos = idx >> 5, j = idx & 31;
      const float inv = powf(10000.f, -(float)(2 * j) / 64.f);
      const float ang = (float)pos * inv;
      ((float*)(p.ws + OFF_ROPE))[idx] = cosf(ang);
      ((float*)(p.ws + OFF_ROPE))[65536 + idx] = sinf(ang);
    }
  }
  constexpr int TT = NU - U0;
  int t0i = vb, tsi = nb;
  if (nb >= 2 * N_ADA) { if (vb < N_ADA) return; t0i = vb - N_ADA; tsi = nb - N_ADA; }
  for (int t = t0i; t < TT; t += 2 * tsi) {
    const bool two = t + tsi < TT;
    const TrTile ta = tr_tile(p, t);
    const TrTile tb = tr_tile(p, two ? t + tsi : t);
    transpose_pair(smem, ta, tb, two);
  }
}

DI float wave_sum(float v) {
#pragma unroll
  for (int o = 32; o > 0; o >>= 1) v += __shfl_xor(v, o);
  return v;
}
DI void phase_prep0(const Params& p, char* smem, int vb, int nb) {
  const int tid = tidx(), lane = tid & 63, w = tid >> 6;
  const float* ada = (const float*)(p.ws + OFF_ADA);
  for (int u = vb; u < 448; u += nb) {
    int l, cg;
    if (u < 96) { l = 0; cg = u; } else if (u < 224) { l = 1; cg = u - 96; } else if (u < 320) { l = 2; cg = u - 224; } else { l = 3; cg = u - 320; }
    const bf16_t* Wt = (l & 1) ? (const bf16_t*)(p.ws + OFF_WIO) + (size_t)(l >> 1) * 4096 * 1024 : (const bf16_t*)(p.ws + OFF_WIE) + (size_t)(l >> 1) * 3072 * 1024;
    float* sh = (float*)smem;
    __syncthreads();
    for (int k = tid; k < 8192; k += 256) sh[k] = ada[(size_t)(l * 8 + (k >> 10)) * 3072 + (k & 1023)];
    __syncthreads();
    float* bias = (float*)(p.ws + OFF_BIAS) + (size_t)l * 8 * 4096;
    for (int j = 0; j < 8; ++j) {
      const int n = cg * 32 + w * 8 + j;
      const u32x4 q0 = *(const u32x4*)(Wt + (size_t)n * 1024 + lane * 16), q1 = *(const u32x4*)(Wt + (size_t)n * 1024 + lane * 16 + 8);
      float wv[16];
#pragma unroll
      for (int e = 0; e < 4; ++e) { wv[2 * e] = bflo(q0[e]); wv[2 * e + 1] = bfhi(q0[e]); wv[8 + 2 * e] = bflo(q1[e]); wv[8 + 2 * e + 1] = bfhi(q1[e]); }
#pragma unroll
      for (int b = 0; b < 8; ++b) {
        float a = 0.f;
#pragma unroll
        for (int e4 = 0; e4 < 4; ++e4) {
          const f32x4 sv = *(const f32x4*)(sh + b * 1024 + lane * 16 + 4 * e4);
          a += sv[0] * wv[4 * e4] + sv[1] * wv[4 * e4 + 1] + sv[2] * wv[4 * e4 + 2] + sv[3] * wv[4 * e4 + 3];
        }
        a = wave_sum(a);
        if (lane == 0) bias[b * 4096 + n] = a;
      }
    }
  }
  for (int k = vb * 256 + tid; k < 1024; k += nb * 256) {
    const float* pb = (const float*)(p.ws + OFF_PEB) + (k >> 8) * 16 * 256 + (k & 255);
    float a = 0.f;
#pragma unroll
    for (int ch = 0; ch < 16; ++ch) a += pb[ch * 256];
    ((float*)(p.ws + OFF_PEBF))[k] = a;
  }
  for (int k = vb * 256 + tid; k < 4 * 8 * 1024; k += nb * 256) {
    const int l = k >> 13, b = (k >> 10) & 7, c = k & 1023;
    ((float*)(p.ws + OFF_GG))[k] = p.norm_g[l * 1024 + c] * (1.f + ada[(size_t)(l * 8 + b) * 3072 + 1024 + c]);
  }
  bf16_t* A2 = (bf16_t*)(p.ws + OFF_A2);
  float* rowss = (float*)(p.ws + OFF_ROWSS);
  float4 gw[4];
#pragma unroll
  for (int k = 0; k < 4; ++k) gw[k] = *(const float4*)(p.norm_g + k * 256 + lane * 4);
  const int rstep = nb * 4;
  for (int row = vb * 4 + w; row < T_; row += 2 * rstep) {
    const int row1 = row + rstep;
    const bool has1 = row1 < T_;
    const float* xr0 = p.x + (size_t)row * 1024;
    const float* xr1 = p.x + (size_t)(has1 ? row1 : row) * 1024;
    float4 v0[4], v1[4], s0[4], s1[4];
#pragma unroll
    for (int k = 0; k < 4; ++k) { v0[k] = *(const float4*)(xr0 + k * 256 + lane * 4); v1[k] = *(const float4*)(xr1 + k * 256 + lane * 4); }
#pragma unroll
    for (int k = 0; k < 4; ++k) {
      s0[k] = *(const float4*)(ada + (size_t)(row >> 11) * 3072 + 1024 + k * 256 + lane * 4);
      s1[k] = *(const float4*)(ada + (size_t)((has1 ? row1 : row) >> 11) * 3072 + 1024 + k * 256 + lane * 4);
    }
    float ss0 = 0.f, ss1 = 0.f;
#pragma unroll
    for (int k = 0; k < 4; ++k) {
      ss0 += v0[k].x * v0[k].x + v0[k].y * v0[k].y + v0[k].z * v0[k].z + v0[k].w * v0[k].w;
      ss1 += v1[k].x * v1[k].x + v1[k].y * v1[k].y + v1[k].z * v1[k].z + v1[k].w * v1[k].w;
    }
    ss0 = wave_sum(ss0); ss1 = wave_sum(ss1);
    if (lane == 0) { rowss[row] = ss0; if (has1) rowss[row1] = ss1; }
#pragma unroll
    for (int k = 0; k < 4; ++k) {
      const int col = k * 256 + lane * 4;
      const float4 g = gw[k];
      uint2 o;
      o.x = pk2(v0[k].x * g.x * (1.f + s0[k].x), v0[k].y * g.y * (1.f + s0[k].y)); o.y = pk2(v0[k].z * g.z * (1.f + s0[k].z), v0[k].w * g.w * (1.f + s0[k].w));
      *(uint2*)(A2 + (size_t)row * 1024 + col) = o;
      if (has1) {
        o.x = pk2(v1[k].x * g.x * (1.f + s1[k].x), v1[k].y * g.y * (1.f + s1[k].y)); o.y = pk2(v1[k].z * g.z * (1.f + s1[k].z), v1[k].w * g.w * (1.f + s1[k].w));
        *(uint2*)(A2 + (size_t)row1 * 1024 + col) = o;
      }
    }
  }
}
DI void phase_final(const Params& p, int vb, int nb) {
  const int lane = tidx() & 63, w = tidx() >> 6;
  const float* rowss = (const float*)(p.ws + OFF_ROWSS) + 4 * T_;
  float4 gw[4];
#pragma unroll
  for (int k = 0; k < 4; ++k) gw[k] = *(const float4*)(p.final_g + k * 256 + lane * 4);
  const int rstep = nb * 4;
  for (int row = vb * 4 + w; row < T_; row += 2 * rstep) {
    const int row1 = row + rstep;
    const bool has1 = row1 < T_;
    float* xr0 = p.out + (size_t)row * 1024;
    float* xr1 = p.out + (size_t)(has1 ? row1 : row) * 1024;
    float4 v0[4], v1[4];
#pragma unroll
    for (int k = 0; k < 4; ++k) { v0[k] = *(const float4*)(xr0 + k * 256 + lane * 4); v1[k] = *(const float4*)(xr1 + k * 256 + lane * 4); }
    const float rs0 = rsqrtf(rowss[row] * (1.f / 1024.f) + 1e-6f), rs1 = rsqrtf(rowss[has1 ? row1 : row] * (1.f / 1024.f) + 1e-6f);
#pragma unroll
    for (int k = 0; k < 4; ++k) {
      const float4 g = gw[k];
      float4 o; o.x = v0[k].x * rs0 * g.x; o.y = v0[k].y * rs0 * g.y; o.z = v0[k].z * rs0 * g.z; o.w = v0[k].w * rs0 * g.w;
      *(float4*)(xr0 + k * 256 + lane * 4) = o;
    }
    if (has1) {
#pragma unroll
      for (int k = 0; k < 4; ++k) {
        const float4 g = gw[k];
        float4 o; o.x = v1[k].x * rs1 * g.x; o.y = v1[k].y * rs1 * g.y; o.z = v1[k].z * rs1 * g.z; o.w = v1[k].w * rs1 * g.w;
        *(float4*)(xr1 + k * 256 + lane * 4) = o;
      }
    }
  }
}
DI void apply_rs_bias(f32x16 (&acc)[2][2], const float* rowss, const float* bias, int row0, int col0, int lane) {
  const int t = lane & 31, h = lane >> 5;
  const float rs0 = rsqrtf(rowss[row0 + t] * (1.f / 1024.f) + 1e-6f), rs1 = rsqrtf(rowss[row0 + 32 + t] * (1.f / 1024.f) + 1e-6f);
#pragma unroll
  for (int ni = 0; ni < 2; ++ni)
#pragma unroll
    for (int a = 0; a < 4; ++a) {
      const f32x4 bv = *(const f32x4*)(bias + col0 + 32 * ni + 8 * a + 4 * h);
#pragma unroll
      for (int bb = 0; bb < 4; ++bb) {
        acc[0][ni][4 * a + bb] = acc[0][ni][4 * a + bb] * rs0 + bv[bb];
        acc[1][ni][4 * a + bb] = acc[1][ni][4 * a + bb] * rs1 + bv[bb];
      }
    }
}

DI void phase_g1_even(const Params& p, char* smem, int li, int vb, int nb) {
  const bf16_t* H = (const bf16_t*)(p.ws + OFF_A2);
  const float* rowss = (const float*)(p.ws + OFF_ROWSS) + (size_t)(2 * li) * T_;
  const float* biasl = (const float*)(p.ws + OFF_BIAS) + (size_t)(2 * li) * 8 * 4096;
  const bf16_t* Wt = (const bf16_t*)(p.ws + OFF_WIE) + (size_t)li * 3072 * 1024;
  const float* cosT = (const float*)(p.ws + OFF_ROPE);
  const float* sinT = cosT + 65536;
  char* ws = p.ws;
  auto epi = [&](f32x16 (&acc)[2][2], int row0, int col0, int lane, char* wsm) {
    const int ct = col0 >> 6, b = row0 >> 11, s0 = row0 & 2047;
    if (ct >= 47) return;
    apply_rs_bias(acc, rowss, biasl + b * 4096, row0, col0, lane);
    int mode;
    bf16_t* dst; int ld;
    if (ct < 8) { mode = 1; dst = (bf16_t*)(ws + E_QA) + (size_t)row0 * 512 + ct * 64; ld = 512; }
    else if (ct == 8) { mode = 1; dst = (bf16_t*)(ws + E_KA) + (size_t)row0 * 64; ld = 64; }
    else if (ct == 9) { mode = 2; dst = (bf16_t*)(ws + E_VAT) + (size_t)b * 64 * 2048 + s0; ld = 2048; }
    else if (ct < 18) { mode = 0; dst = (bf16_t*)(ws + E_ZA) + (size_t)row0 * 512 + (ct - 10) * 64; ld = 512; }
    else if (ct < 26) { mode = 1; dst = (bf16_t*)(ws + E_QB) + (size_t)row0 * 512 + (ct - 18) * 64; ld = 512; }
    else if (ct < 28) { mode = 1; dst = (bf16_t*)(ws + E_KC) + ((size_t)(b * 2 + ct - 26) * 2048 + s0) * 64; ld = 64; }
    else if (ct < 30) { mode = 0; dst = (bf16_t*)(ws + E_VC) + ((size_t)(b * 2 + ct - 28) * 2048 + s0) * 64; ld = 64; }
    else if (ct < 32) { mode = 1; dst = (bf16_t*)(ws + E_KS) + (size_t)row0 * 128 + (ct - 30) * 64; ld = 128; }
    else if (ct < 34) { mode = 2; dst = (bf16_t*)(ws + E_VST) + (size_t)(b * 2 + ct - 32) * 64 * 2048 + s0; ld = 2048; }
    else if (ct < 36) { mode = 1; dst = (bf16_t*)(ws + E_KW) + (size_t)row0 * 128 + (ct - 34) * 64; ld = 128; }
    else if (ct < 38) { mode = 2; dst = (bf16_t*)(ws + E_VWT) + (size_t)(b * 2 + ct - 36) * 64 * 2048 + s0; ld = 2048; }
    else if (ct < 46) { mode = 0; dst = (bf16_t*)(ws + E_ZB) + (size_t)row0 * 512 + (ct - 38) * 64; ld = 512; }
    else if (ct == 46) { mode = 3; dst = nullptr; ld = 0; }
    else { mode = 4; dst = nullptr; ld = 0; }
    if (mode == 0) st_rm(acc, wsm, dst, ld, lane);
    else if (mode == 1) st_rm_rope(acc, wsm, dst, ld, lane, cosT, sinT, s0);
    else if (mode == 2) st_tr(acc, wsm, dst, ld, lane, -1);
    else if (mode == 3) {
      float* GB = (float*)(ws + E_GB);
      const int t = lane & 31, h = lane >> 5;
#pragma unroll
      for (int mi = 0; mi < 2; ++mi)
#pragma unroll
        for (int a = 0; a < 3; ++a) {
          float4 o; o.x = acc[mi][0][4 * a]; o.y = acc[mi][0][4 * a + 1]; o.z = acc[mi][0][4 * a + 2]; o.w = acc[mi][0][4 * a + 3];
          *(float4*)(GB + (size_t)(row0 + 32 * mi + t) * 24 + 8 * a + 4 * h) = o;
        }
    }
  };
  gemm_tiles(smem, H, [](int r) { return (size_t)r * 1024; }, Wt, 1024, 1024, 128, 12, vb, nb, epi, true);
}
DI void phase_g1_odd(const Params& p, char* smem, int li, int vb, int nb) {
  const bf16_t* H = (const bf16_t*)(p.ws + OFF_A2);
  float* kmean = (float*)(p.ws + OFF_KMEAN) + (size_t)li * 65536;
  const float* rowss = (const float*)(p.ws + OFF_ROWSS) + (size_t)(2 * li + 1) * T_;
  const float* biasl = (const float*)(p.ws + OFF_BIAS) + (size_t)(2 * li + 1) * 8 * 4096;
  const bf16_t* Wt = (const bf16_t*)(p.ws + OFF_WIO) + (size_t)li * 4096 * 1024;
  const float* cosT = (const float*)(p.ws + OFF_ROPE);
  const float* sinT = cosT + 65536;
  char* ws = p.ws;
  auto epi = [&](f32x16 (&acc)[2][2], int row0, int col0, int lane, char* wsm) {
    const int ct = col0 >> 6, b = row0 >> 11, s0 = row0 & 2047;
    apply_rs_bias(acc, rowss, biasl + b * 4096, row0, col0, lane);
    if (ct < 32) {
      st_rm_rope(acc, wsm, (bf16_t*)(ws + (ct < 16 ? O_Q : O_K)) + (size_t)row0 * 1024 + (ct & 15) * 64, 1024, lane, cosT, sinT, s0);
      if (ct >= 16) {
        const bf16_t* img = (const bf16_t*)wsm + lane;
        float cs = 0.f;
#pragma unroll 16
        for (int r = 0; r < 64; ++r) cs += bf2f(img[r * 72]);
        atomicAdd(kmean + (((size_t)b * 16 + (ct - 16)) * 8 + (s0 >> 8)) * 64 + lane, cs * (1.f / 256.f));
      }
    }
    else if (ct < 48) st_tr(acc, wsm, (bf16_t*)(ws + O_VT) + (size_t)(b * 16 + ct - 32) * 64 * 2048 + s0, 2048, lane, -1);
    else st_rm(acc, wsm, (bf16_t*)(ws + O_Z) + (size_t)row0 * 1024 + (ct - 48) * 64, 1024, lane);
  };
  gemm_tiles(smem, H, [](int r) { return (size_t)r * 1024; }, Wt, 1024, 1024, 128, 16, vb, nb, epi, true);
}
DI void phase_out(const Params& p, char* smem, int layer, int vb, int nb) {
  const bf16_t* AO = (const bf16_t*)(p.ws + OFF_H);
  const bf16_t* Wt = (const bf16_t*)(p.ws + ((layer & 1) ? OFF_WOO : OFF_WOE)) + (size_t)(layer >> 1) * 1024 * 1024;
  const float* xin = layer == 0 ? p.x : p.out;
  float* xo = p.out;
  const float* ada = (const float*)(p.ws + OFF_ADA);
  bf16_t* A2 = (bf16_t*)(p.ws + OFF_A2);
  float* rowss = (float*)(p.ws + OFF_ROWSS) + (size_t)(layer + 1) * T_;
  const float* ggn = (const float*)(p.ws + OFF_GG) + (size_t)(layer < 3 ? layer + 1 : 3) * 8 * 1024;
  auto epi = [&](const f32x16 (&acc)[2][2], int row0, int col0, int lane, char* wsm) {
    const int t = lane & 31, h = lane >> 5, b = row0 >> 11;
    float* img = (float*)wsm;
    const int rr = lane >> 4, cc = (lane & 15) * 4;
    const f32x4 gate = *(const f32x4*)(ada + (size_t)(layer * 8 + b) * 3072 + 2048 + col0 + cc);
    const f32x4 gg = *(const f32x4*)(ggn + b * 1024 + col0 + cc);
#pragma unroll
    for (int mi = 0; mi < 2; ++mi) {
#pragma unroll
      for (int ni = 0; ni < 2; ++ni)
#pragma unroll
        for (int a = 0; a < 4; ++a) {
          f32x4 o; o[0] = acc[mi][ni][4 * a]; o[1] = acc[mi][ni][4 * a + 1]; o[2] = acc[mi][ni][4 * a + 2]; o[3] = acc[mi][ni][4 * a + 3];
          *(f32x4*)(img + t * 68 + 32 * ni + 8 * a + 4 * h) = o;
        }
      asm volatile("" ::: "memory");
      f32x4 xv[8];
#pragma unroll
      for (int ps = 0; ps < 8; ++ps) xv[ps] = *(const f32x4*)(xin + (size_t)(row0 + 32 * mi + ps * 4 + rr) * 1024 + col0 + cc);
#pragma unroll
      for (int ps = 0; ps < 8; ++ps) {
        const int row = ps * 4 + rr;
        const f32x4 y = *(const f32x4*)(img + row * 68 + cc);
        const size_t o = (size_t)(row0 + 32 * mi + row) * 1024 + col0 + cc;
        const f32x4 xn = xv[ps] + gate * y;
        *(f32x4*)(xo + o) = xn;
        if (layer < 3) { uint2 a2; a2.x = pk2(xn[0] * gg[0], xn[1] * gg[1]); a2.y = pk2(xn[2] * gg[2], xn[3] * gg[3]); *(uint2*)(A2 + o) = a2; }
        float sq = xn[0] * xn[0] + xn[1] * xn[1] + xn[2] * xn[2] + xn[3] * xn[3];
        sq += __shfl_xor(sq, 1); sq += __shfl_xor(sq, 2); sq += __shfl_xor(sq, 4); sq += __shfl_xor(sq, 8);
        if ((lane & 15) == 0) atomicAdd(rowss + row0 + 32 * mi + row, sq);
      }
      asm volatile("" ::: "memory");
    }
  };
  gemm_tiles(smem, AO, [](int r) { return (size_t)r * 1024; }, Wt, 1024, 1024, 128, 4, vb, nb, epi, true);
}

DI void mlp1_tile(const Params& p, char* smem, int li, int t) {
  const int ks = t & 3, kv = t >> 6, tt = (t >> 2) & 15, lk = li * 2 + kv;
  const bf16_t* A = (const bf16_t*)(p.ws + (kv ? E_VC : E_KC)) + ks * 512;
  const bf16_t* Wt = (const bf16_t*)(p.ws + OFF_W1) + (size_t)lk * 256 * 2048 + ks * 512;
  float* part = (float*)(p.ws + OFF_PART) + (size_t)(ks * 2 + kv) * 2048 * 256;
  auto epi = [&](const f32x16 (&acc)[2][2], int row0, int col0, int lane, char* wsm) {
    const int t2 = lane & 31, h = lane >> 5;
#pragma unroll
    for (int mi = 0; mi < 2; ++mi)
#pragma unroll
      for (int ni = 0; ni < 2; ++ni)
#pragma unroll
        for (int a = 0; a < 4; ++a) {
          f32x4 o; o[0] = acc[mi][ni][4 * a]; o[1] = acc[mi][ni][4 * a + 1]; o[2] = acc[mi][ni][4 * a + 2]; o[3] = acc[mi][ni][4 * a + 3];
          *(f32x4*)(part + (size_t)(row0 + 32 * mi + t2) * 256 + col0 + 32 * ni + 8 * a + 4 * h) = o;
        }
  };
  gemm_tiles(smem, A, [](int r) { return (size_t)(r >> 7) * 131072 + (size_t)(r & 127) * 1024; }, Wt, 2048, 512, 16, 1, tt, 1 << 30, epi);
}
DI void hid_rows(const Params& p, int li, int kv, int row_base) {
  const float* part = (const float*)(p.ws + OFF_PART);
  bf16_t* Hd = (bf16_t*)(p.ws + OFF_HID);
  const int base_idx = (kv * 2048 + row_base) * 64;
  constexpr size_t PSTR = (size_t)2 * 2048 * 256;
  const float* pebf = (const float*)(p.ws + OFF_PEBF) + (li * 2 + kv) * 256;
  for (int j0 = tidx(); j0 < 128 * 64; j0 += 4 * 256) {
    f32x4 pv[4][5];
#pragma unroll
    for (int q = 0; q < 4; ++q) {
      const int idx = base_idx + j0 + q * 256;
      const size_t e = (size_t)idx * 4;
#pragma unroll
      for (int k = 0; k < 4; ++k) pv[q][k] = *(const f32x4*)(part + k * PSTR + e);
      pv[q][4] = *(const f32x4*)(pebf + (idx & 63) * 4);
    }
#pragma unroll
    for (int q = 0; q < 4; ++q) {
      const int idx = base_idx + j0 + q * 256;
      const size_t e = (size_t)idx * 4;
      const f32x4 v = (pv[q][0] + pv[q][1]) + (pv[q][2] + pv[q][3]) + pv[q][4];
      float g[4];
#pragma unroll
      for (int bb = 0; bb < 4; ++bb) {
        const float xv = v[bb];
        const float uu = 0.7978845608028654f * (xv + 0.044715f * xv * xv * xv);
        const float th = 1.f - 2.f / (__expf(2.f * uu) + 1.f);
        g[bb] = 0.5f * xv * (1.f + th);
      }
      uint2 o; o.x = pk2(g[0], g[1]); o.y = pk2(g[2], g[3]);
      *(uint2*)(Hd + e) = o;
    }
  }
  asm volatile("s_waitcnt vmcnt(0)" ::: "memory");
  __syncthreads();
}
DI void mlp2_tile(const Params& p, char* smem, int li, int t) {
  const int kv = t >> 4, tt = t & 15, lk = li * 2 + kv;
  hid_rows(p, li, kv, tt * 128);
  const bf16_t* A = (const bf16_t*)(p.ws + OFF_HID) + (size_t)kv * 2048 * 256;
  const bf16_t* Wt = (const bf16_t*)(p.ws + OFF_W2) + (size_t)lk * 256 * 256;
  bf16_t* KC = (bf16_t*)(p.ws + OFF_KCMP);
  bf16_t* VT = (bf16_t*)(p.ws + OFF_VCMPT);
  auto epi = [&](const f32x16 (&acc)[2][2], int row0, int col0, int lane, char* wsm) {
    if (col0 != 0) return;
    const int bg = row0 >> 7, c0 = row0 & 127;
    if (kv == 0) {
      f32x16 g[2][2];
      const int t = lane & 31;
#pragma unroll
      for (int mi = 0; mi < 2; ++mi)
#pragma unroll
        for (int ni = 0; ni < 2; ++ni)
#pragma unroll
          for (int r = 0; r < 16; ++r) g[mi][ni][r] = (c0 + 32 * mi + t == 127) ? 0.f : acc[mi][ni][r];
      st_rm(g, wsm, KC + (size_t)row0 * 64, 64, lane);
    } else {
      st_tr(acc, wsm, VT + (size_t)bg * 64 * 128 + c0, 128, lane, 127 - c0);
    }
  };
  gemm_tiles(smem, A, [](int r) { return (size_t)r * 256; }, Wt, 256, 256, 16, 1, tt, 1 << 30, epi);
}

constexpr float LAZY = 6.f;
#define TILE_ISSUE(key0_)                                                          \
  do {                                                                             \
    const int kk_ = (key0_);                                                       \
    gk0 = *(const u32x4*)(K + (size_t)(kk_ + ldr) * kstride + ldc);                \
    gk1 = *(const u32x4*)(K + (size_t)(kk_ + ldr + 32) * kstride + ldc);           \
    gv0 = *(const u32x4*)(V + (size_t)(ldr) * vstride + kk_ + ldc);                \
    gv1 = *(const u32x4*)(V + (size_t)(ldr + 32) * vstride + kk_ + ldc);           \
  } while (0)
#define TILE_STORE(Kb_)                                                            \
  do {                                                                             \
    bf16_t* kb_ = (Kb_);                                                           \
    *(u32x4*)(kb_ + ldr * 72 + ldc) = gk0;                                         \
    *(u32x4*)(kb_ + (ldr + 32) * 72 + ldc) = gk1;                                  \
    *(u32x4*)(kb_ + 64 * 72 + ldr * 72 + ldc) = gv0;                               \
    *(u32x4*)(kb_ + 64 * 72 + (ldr + 32) * 72 + ldc) = gv1;                        \
  } while (0)
template <int MODE, class MF>
DI void att_tile64(Att& st, const bf16x8 (&qf)[4], const bf16_t* Kb, const bf16_t* Vb, int lane, const MF& mf) {
  const int i = lane & 31, h = lane >> 5;
  const int a = i >> 3, hh = (i >> 2) & 1, b = i & 3;
  const int kperm = 16 * (a >> 1) + 8 * hh + 4 * (a & 1) + b;
  f32x16 sa[2];
#pragma unroll
  for (int sub = 0; sub < 2; ++sub) {
#pragma unroll
    for (int r = 0; r < 16; ++r) sa[sub][r] = 0.f;
#pragma unroll
    for (int s = 0; s < 4; ++s) {
      const bf16x8 kf = *(const bf16x8*)(Kb + (32 * sub + kperm) * 72 + 32 * h + 8 * s);
      sa[sub] = MFMA(kf, qf[s], sa[sub]);
    }
  }
  float mx = NEG_INF;
#pragma unroll
  for (int sub = 0; sub < 2; ++sub)
#pragma unroll
    for (int r = 0; r < 16; ++r) {
      if (MODE == 2 || MODE == 4) {
        const int c = 32 * sub + 16 * (r >> 3) + (r & 7);
        bool ok = c <= mf.lim_hi;
        if (MODE == 4) ok = ok && (c > mf.lim_lo);
        if (!ok) sa[sub][r] = NEG_INF;
      }
      mx = fmaxf(mx, sa[sub][r]);
    }
  mx = fmaxf(mx, __shfl_xor(mx, 32)) * SC2;
  if (MODE == 3) mx = mf.on ? mx : NEG_INF;
  const bool upd = mx > st.m + LAZY;
  if (__any(upd)) {
    const float mnew = upd ? mx : st.m;
    const float alpha = upd ? ex2(st.m - mnew) : 1.f;
    st.m = mnew; st.l *= alpha;
#pragma unroll
    for (int r = 0; r < 16; ++r) { st.o0[r] *= alpha; st.o1[r] *= alpha; }
  }
  float nm = (st.m == NEG_INF) ? 0.f : -st.m;
  if (MODE == 3) nm = mf.on ? nm : NEG_INF;
  float sum = 0.f;
#pragma unroll
  for (int sub = 0; sub < 2; ++sub)
#pragma unroll
    for (int r = 0; r < 16; ++r) { const float e = ex2(__builtin_fmaf(sa[sub][r], SC2, nm)); sa[sub][r] = e; sum += e; }
  st.l += sum;
#pragma unroll
  for (int sub = 0; sub < 2; ++sub)
#pragma unroll
    for (int s2 = 0; s2 < 2; ++s2) {
      union { bf16x8 v; unsigned u[4]; } t;
#pragma unroll
      for (int j = 0; j < 4; ++j) t.u[j] = pk2(sa[sub][8 * s2 + 2 * j], sa[sub][8 * s2 + 2 * j + 1]);
      const bf16x8 vf0 = *(const bf16x8*)(Vb + (i) * 72 + 32 * sub + 16 * s2 + 8 * h);
      const bf16x8 vf1 = *(const bf16x8*)(Vb + (32 + i) * 72 + 32 * sub + 16 * s2 + 8 * h);
      st.o0 = MFMA(vf0, t.v, st.o0);
      st.o1 = MFMA(vf1, t.v, st.o1);
    }
}
template <class MF>
DI void att_stream(char* smem, Att& st, const bf16x8 (&qf)[4], const bf16_t* __restrict__ K, int kstride, const bf16_t* __restrict__ V, int vstride,
                   int tlo, int thi, int lane, MF& mf) {
  bf16_t* base = (bf16_t*)smem;
  u32x4 gk0, gk1, gv0, gv1;
  const int ldt = tidx(), ldr = ldt >> 3, ldc = (ldt & 7) * 8;
  __syncthreads();
  TILE_ISSUE(tlo * 64);
  TILE_STORE(base);
  TILE_ISSUE(((tlo + 1 <= thi) ? tlo + 1 : tlo) * 64);
  __syncthreads();
  for (int t = tlo; t <= thi; ++t) {
    const int cur = (t - tlo) & 1;
    bf16_t* Kb = base + cur * (2 * 64 * 72);
    bf16_t* Kn = base + (cur ^ 1) * (2 * 64 * 72);
    if (t + 1 <= thi) TILE_STORE(Kn);
    if (t + 2 <= thi) TILE_ISSUE((t + 2) * 64);
    const int c = mf.cls(t * 64);
    if (c == 1) att_tile64<1>(st, qf, Kb, Kb + 64 * 72, lane, mf);
    else if (c == 2) att_tile64<2>(st, qf, Kb, Kb + 64 * 72, lane, mf);
    else if (c == 3) att_tile64<3>(st, qf, Kb, Kb + 64 * 72, lane, mf);
    else if (c == 4) att_tile64<4>(st, qf, Kb, Kb + 64 * 72, lane, mf);
    __syncthreads();
  }
}
struct MaskWin {
  int token, t0, win, h8; int lim_hi, lim_lo; bool on;
  DI int cls(int key0) {
    if (key0 > t0 + 31 || key0 + 63 <= t0 - win) return 0;
    const bool lo_ok = key0 > t0 + 31 - win;
    if (key0 + 63 <= t0 && lo_ok) return 1;
    lim_hi = token - key0 - h8; lim_lo = token - win - key0 - h8;
    return lo_ok ? 2 : 4;
  }
};
struct MaskSel {
  unsigned sel; int token, t0, h8; int lim_hi, lim_lo; bool on;
  DI int cls(int key0) {
    on = (sel >> (key0 >> 6)) & 1u;
    const unsigned long long bal = __ballot(on);
    if (bal == 0ull || key0 > t0 + 31) return 0;
    if (key0 + 63 <= t0) return bal == ~0ull ? 1 : 3;
    lim_hi = on ? token - key0 - h8 : -1;
    return 2;
  }
};
struct MaskMoba {
  unsigned sel; int token, t0, ob, h8; int lim_hi, lim_lo; bool on;
  DI int cls(int key0) {
    if (key0 < ob * 256) {
      on = (sel >> (key0 >> 8)) & 1u;
      const unsigned long long bal = __ballot(on);
      return bal == 0ull ? 0 : (bal == ~0ull ? 1 : 3);
    }
    if (key0 > t0 + 31) return 0;
    if (key0 + 63 <= t0) return 1;
    lim_hi = token - key0 - h8;
    return 2;
  }
};

DI void swa_unit(const Params& p, char* smem, int li, int u) {
  const int lane = tidx() & 63, w = tidx() >> 6, i = lane & 31, h = lane >> 5;
  const int b = u >> 7, tt = (u >> 1) & 63, hg = u & 1, head = hg * 4 + w, t0 = tt * 32, token = t0 + i;
  const size_t grow = (size_t)b * S_ + token;
  const bf16_t* qp = (const bf16_t*)(p.ws + E_QA) + grow * 512 + head * 64 + 32 * h;
  bf16x8 qf[4];
#pragma unroll
  for (int s = 0; s < 4; ++s) qf[s] = *(const bf16x8*)(qp + 8 * s);
  const bf16_t* Kp = (const bf16_t*)(p.ws + E_KA) + (size_t)b * S_ * 64;
  const bf16_t* Vp = (const bf16_t*)(p.ws + E_VAT) + (size_t)b * 64 * S_;
  Att st;
  att_init(st, p.a_sinks[li * 8 + head] * LOG2E, h == 0 ? 1.f : 0.f);
  int k0 = t0 - 128; if (k0 < 0) k0 = 0;
  MaskWin mf{token, t0, 128, 8 * h, 0, 0, true};
  att_stream(smem, st, qf, Kp, 64, Vp, S_, k0 >> 6, t0 >> 6, lane, mf);
  const float inv = att_invl(st);
#pragma unroll
  for (int r = 0; r < 16; ++r) { st.o0[r] *= inv; st.o1[r] *= inv; }
  store_out(st.o0, st.o1, (const bf16_t*)(p.ws + E_ZA) + grow * 512 + head * 64, (bf16_t*)(p.ws + OFF_H) + grow * 1024 + head * 64, h);
}

DI void nsa_win_unit(const Params& p, char* smem, int u) {
  const int tid = tidx(), lane = tid & 63, w = tid >> 6, i = lane & 31, h = lane >> 5;
  const int b = u >> 7, g = (u >> 6) & 1, tt = u & 63, t0 = tt * 32, token = t0 + i, head = g * 4 + w, bg = b * 2 + g;
  const size_t grow = (size_t)b * S_ + token;
  const bf16_t* qp = (const bf16_t*)(p.ws + E_QB) + grow * 512 + head * 64 + 32 * h;
  bf16x8 qf[4];
#pragma unroll
  for (int s = 0; s < 4; ++s) qf[s] = *(const bf16x8*)(qp + 8 * s);
  const float gl2 = ((const float*)(p.ws + E_GB))[grow * 24 + head * 3 + 2];
  const float g2 = 1.f / (1.f + __expf(-gl2));
  const bf16_t* Kp = (const bf16_t*)(p.ws + E_KW) + (size_t)b * S_ * 128 + g * 64;
  const bf16_t* Vp = (const bf16_t*)(p.ws + E_VWT) + (size_t)bg * 64 * S_;
  Att st; att_init(st, NEG_INF, 0.f);
  int k0 = t0 - 512; if (k0 < 0) k0 = 0;
  MaskWin mf{token, t0, 512, 8 * h, 0, 0, true};
  att_stream(smem, st, qf, Kp, 128, Vp, S_, k0 >> 6, t0 >> 6, lane, mf);
  const float inv = att_invl(st) * g2;
  bf16_t* ow = (bf16_t*)(p.ws + OFF_OWIN) + grow * 512 + head * 64 + 4 * h;
#pragma unroll
  for (int a = 0; a < 4; ++a) {
    u32x2 o0, o1;
    o0[0] = pk2(st.o0[4 * a] * inv, st.o0[4 * a + 1] * inv); o0[1] = pk2(st.o0[4 * a + 2] * inv, st.o0[4 * a + 3] * inv);
    o1[0] = pk2(st.o1[4 * a] * inv, st.o1[4 * a + 1] * inv); o1[1] = pk2(st.o1[4 * a + 2] * inv, st.o1[4 * a + 3] * inv);
    *(u32x2*)(ow + 8 * a) = o0;
    *(u32x2*)(ow + 32 + 8 * a) = o1;
  }
}
DI void nsa_unit(const Params& p, char* smem, int u) {
  float* imp_s = (float*)smem;
  float* sc_s = imp_s + 4096;
  unsigned* sel_s = (unsigned*)(sc_s + 32 * 33);
  unsigned* uni_s = sel_s + 32;
  const int tid = tidx(), lane = tid & 63, w = tid >> 6, i = lane & 31, h = lane >> 5;
  const int b = u >> 7, g = (u >> 6) & 1, tt = u & 63, t0 = tt * 32, token = t0 + i, head = g * 4 + w, bg = b * 2 + g;
  const size_t grow = (size_t)b * S_ + token;
  __syncthreads();
  for (int k = tid; k < 4096; k += 256) imp_s[k] = 0.f;
  if (tid == 0) *uni_s = 0u;
  __syncthreads();
  const bf16_t* qp = (const bf16_t*)(p.ws + E_QB) + grow * 512 + head * 64 + 32 * h;
  bf16x8 qf[4];
#pragma unroll
  for (int s = 0; s < 4; ++s) qf[s] = *(const bf16x8*)(qp + 8 * s);
  const float* gl = (const float*)(p.ws + E_GB) + grow * 24 + head * 3;
  const float g0 = 1.f / (1.f + __expf(-gl[0])), g1 = 1.f / (1.f + __expf(-gl[1])), g2 = 1.f / (1.f + __expf(-gl[2]));

  const bf16_t* Kc = (const bf16_t*)(p.ws + OFF_KCMP) + (size_t)bg * 128 * 64;
  const bf16_t* Vc = (const bf16_t*)(p.ws + OFF_VCMPT) + (size_t)bg * 64 * 128;
  const int ntile = (t0 >> 9) + 1;
  float m = NEG_INF, l = 0.f;
  bf16x8 kcur[4];
  load_kf(kcur, Kc, 64, 0, lane);
  for (int T = 0; T < ntile; ++T) {
    bf16x8 knxt[4];
    load_kf(knxt, Kc, 64, (T + 1 < ntile ? T + 1 : 0) * 32, lane);
    const f32x16 sa = qk_mfma(kcur, qf);
#pragma unroll
    for (int s = 0; s < 4; ++s) kcur[s] = knxt[s];
    float pv[16]; float mx = NEG_INF;
#pragma unroll
    for (int r = 0; r < 16; ++r) {
      const int c = T * 32 + 16 * (r >> 3) + 8 * h + (r & 7);
      const float v = (16 * c + 31 <= token) ? sa[r] * SC2 : NEG_INF;
      pv[r] = v; mx = fmaxf(mx, v);
    }
    mx = fmaxf(mx, __shfl_xor(mx, 32));
    const float mnew = fmaxf(m, mx), msafe = (mnew == NEG_INF) ? 0.f : mnew;
    const float alpha = ex2(m - msafe);
    float sum = 0.f;
#pragma unroll
    for (int r = 0; r < 16; ++r) sum += ex2(pv[r] - msafe);
    l = l * alpha + sum; m = mnew;
  }
  l = l + __shfl_xor(l, 32);
  const float invl = l > 0.f ? 1.f / l : 0.f, msafe = (m == NEG_INF) ? 0.f : m;
  f32x16 ot0, ot1;
  {
    f32x16 oc0, oc1;
#pragma unroll
    for (int r = 0; r < 16; ++r) { oc0[r] = 0.f; oc1[r] = 0.f; }
    for (int T = 0; T < ntile; ++T) {
      bf16x8 knxt[4];
      load_kf(knxt, Kc, 64, (T + 1 < ntile ? T + 1 : T) * 32, lane);
      bf16x8 vf[2][2];
      load_v(vf, Vc, 128, T * 32, lane);
      const f32x16 sa = qk_mfma(kcur, qf);
#pragma unroll
      for (int s = 0; s < 4; ++s) kcur[s] = knxt[s];
      float pv[16];
#pragma unroll
      for (int r = 0; r < 16; ++r) {
        const int c = T * 32 + 16 * (r >> 3) + 8 * h + (r & 7);
        pv[r] = (16 * c + 31 <= token) ? ex2(sa[r] * SC2 - msafe) * invl : 0.f;
      }
#pragma unroll
      for (int s2 = 0; s2 < 2; ++s2) {
        const int j0 = 8 * T + 4 * s2 + 2 * h;
        const float a0 = pv[8 * s2] + pv[8 * s2 + 1] + pv[8 * s2 + 2] + pv[8 * s2 + 3];
        const float a1 = pv[8 * s2 + 3] + pv[8 * s2 + 4] + pv[8 * s2 + 5] + pv[8 * s2 + 6] + pv[8 * s2 + 7];
        const float a2 = pv[8 * s2 + 7];
        float* ip = imp_s + (w * 32 + i) * 32 + j0;
        atomicAdd(ip, a0);
        atomicAdd(ip + 1, a1);
        if (j0 + 2 < 32) atomicAdd(ip + 2, a2);
      }
      bf16x8 pf[2];
      pack_p(pv, pf);
#pragma unroll
      for (int s2 = 0; s2 < 2; ++s2) { oc0 = MFMA(vf[0][s2], pf[s2], oc0); oc1 = MFMA(vf[1][s2], pf[s2], oc1); }
    }
#pragma unroll
    for (int r = 0; r < 16; ++r) { ot0[r] = g0 * oc0[r]; ot1[r] = g0 * oc1[r]; }
  }
  __syncthreads();
  const int tb = t0 >> 6;
  {
    const int q = tid >> 3, sub = tid & 7;
    float v[4];
#pragma unroll
    for (int jj = 0; jj < 4; ++jj) {
      const int j = sub * 4 + jj;
      const float im = imp_s[(0 * 32 + q) * 32 + j] + imp_s[(1 * 32 + q) * 32 + j] + imp_s[(2 * 32 + q) * 32 + j] + imp_s[(3 * 32 + q) * 32 + j];
      v[jj] = (j > tb) ? NEG_INF : ((j == 0 || j == tb || j == tb - 1) ? 1e4f : im);
    }
    unsigned msk = 0u;
#pragma unroll 1
    for (int rnd = 0; rnd < 8; ++rnd) {
      float best = NEG_INF; int bi = 99;
#pragma unroll
      for (int jj = 0; jj < 4; ++jj) if (v[jj] > best) { best = v[jj]; bi = sub * 4 + jj; }
#pragma unroll
      for (int o = 1; o < 8; o <<= 1) {
        const float ob = __shfl_xor(best, o); const int oi = __shfl_xor(bi, o);
        if (ob > best || (ob == best && oi < bi)) { best = ob; bi = oi; }
      }
      if (best > NEG_INF) {
        msk |= 1u << bi;
#pragma unroll
        for (int jj = 0; jj < 4; ++jj) if (sub * 4 + jj == bi) v[jj] = NEG_INF;
      }
    }
    if (sub == 0) sel_s[q] = msk;
  }
  __syncthreads();
  const unsigned sel = sel_s[i];
  {
    const bf16_t* Kp = (const bf16_t*)(p.ws + E_KS) + (size_t)b * S_ * 128 + g * 64;
    const bf16_t* Vp = (const bf16_t*)(p.ws + E_VST) + (size_t)bg * 64 * S_;
    Att st; att_init(st, NEG_INF, 0.f);
    MaskSel mf{sel, token, t0, 8 * h, 0, 0, true};
    att_stream(smem, st, qf, Kp, 128, Vp, S_, 0, tb, lane, mf);
    const float inv = att_invl(st) * g1;
#pragma unroll
    for (int r = 0; r < 16; ++r) { ot0[r] += inv * st.o0[r]; ot1[r] += inv * st.o1[r]; }
  }
  {
    const bf16_t* ow = (const bf16_t*)(p.ws + OFF_OWIN) + grow * 512 + head * 64 + 4 * h;
    u32x2 wv[8];
#pragma unroll
    for (int k = 0; k < 8; ++k) wv[k] = *(const u32x2*)(ow + 32 * (k >> 2) + 8 * (k & 3));
#pragma unroll
    for (int a = 0; a < 4; ++a) {
      ot0[4 * a] += bflo(wv[a][0]); ot0[4 * a + 1] += bfhi(wv[a][0]); ot0[4 * a + 2] += bflo(wv[a][1]); ot0[4 * a + 3] += bfhi(wv[a][1]);
      ot1[4 * a] += bflo(wv[4 + a][0]); ot1[4 * a + 1] += bfhi(wv[4 + a][0]); ot1[4 * a + 2] += bflo(wv[4 + a][1]); ot1[4 * a + 3] += bfhi(wv[4 + a][1]);
    }
  }
  store_out(ot0, ot1, (const bf16_t*)(p.ws + E_ZB) + grow * 512 + head * 64, (bf16_t*)(p.ws + OFF_H) + grow * 1024 + 512 + head * 64, h);
}

DI void kmean_unit(const Params& p, char* smem, int u) {
  float* red = (float*)smem;
  const int tid = tidx(), lane = tid & 63, w = tid >> 6;
  const int b = u >> 6, j = (u >> 3) & 7, cgp = u & 7, col = cgp * 128 + lane * 2;
  const bf16_t* kp = (const bf16_t*)(p.ws + O_K) + ((size_t)b * S_ + j * 256 + w * 64) * 1024 + col;
  float a0 = 0.f, a1 = 0.f;
#pragma unroll 8
  for (int t = 0; t < 64; ++t) { const unsigned v = *(const unsigned*)(kp + (size_t)t * 1024); a0 += bflo(v); a1 += bfhi(v); }
  __syncthreads();
  red[w * 128 + lane * 2] = a0; red[w * 128 + lane * 2 + 1] = a1;
  __syncthreads();
  if (tid < 128) {
    const float v = (red[tid] + red[128 + tid] + red[256 + tid] + red[384 + tid]) * (1.f / 256.f);
    const int c = cgp * 128 + tid, head = c >> 6, d = c & 63;
    ((float*)(p.ws + OFF_KMEAN))[(((size_t)b * 16 + head) * 8 + j) * 64 + d] = v;
  }
}
DI void moba_unit(const Params& p, char* smem, int li, int u) {
  const int lane = tidx() & 63, w = tidx() >> 6, i = lane & 31, h = lane >> 5;
  const int b = u >> 8, head = (u >> 4) & 15, chunk = u & 15, t0 = chunk * 128 + w * 32, token = t0 + i, ob = t0 >> 8;
  const size_t grow = (size_t)b * S_ + token;
  const bf16_t* qp = (const bf16_t*)(p.ws + O_Q) + grow * 1024 + head * 64 + 32 * h;
  bf16x8 qf[4];
#pragma unroll
  for (int s = 0; s < 4; ++s) qf[s] = *(const bf16x8*)(qp + 8 * s);
  const float* km = (const float*)(p.ws + OFF_KMEAN) + (size_t)li * 65536 + ((size_t)b * 16 + head) * 8 * 64 + 32 * h;
  float gs[7];
#pragma unroll
  for (int j = 0; j < 7; ++j) {
    float a = 0.f;
    if (j < ob) {
#pragma unroll
      for (int s = 0; s < 4; ++s) {
        const float4 k0 = *(const float4*)(km + j * 64 + 8 * s), k1 = *(const float4*)(km + j * 64 + 8 * s + 4);
        union { bf16x8 v; unsigned uu[4]; } t; t.v = qf[s];
        a += bflo(t.uu[0]) * k0.x + bfhi(t.uu[0]) * k0.y + bflo(t.uu[1]) * k0.z + bfhi(t.uu[1]) * k0.w;
        a += bflo(t.uu[2]) * k1.x + bfhi(t.uu[2]) * k1.y + bflo(t.uu[3]) * k1.z + bfhi(t.uu[3]) * k1.w;
      }
      a += __shfl_xor(a, 32);
    }
    gs[j] = a;
  }
  unsigned sel = 0u;
  if (ob <= 3) sel = (1u << ob) - 1u;
  else {
#pragma unroll
    for (int rnd = 0; rnd < 3; ++rnd) {
      float best = NEG_INF; int bi = 0;
#pragma unroll
      for (int j = 0; j < 7; ++j) if (j < ob && !((sel >> j) & 1u) && gs[j] > best) { best = gs[j]; bi = j; }
      sel |= 1u << bi;
    }
  }
  const bf16_t* Kp = (const bf16_t*)(p.ws + O_K) + (size_t)b * S_ * 1024 + head * 64;
  const bf16_t* Vp = (const bf16_t*)(p.ws + O_VT) + (size_t)(b * 16 + head) * 64 * S_;
  Att st; att_init(st, NEG_INF, 0.f);
  MaskMoba mf{sel, token, t0, ob, 8 * h, 0, 0, true};
  att_stream(smem, st, qf, Kp, 1024, Vp, S_, 0, chunk * 2 + 1, lane, mf);
  const float inv = att_invl(st);
#pragma unroll
  for (int r = 0; r < 16; ++r) { st.o0[r] *= inv; st.o1[r] *= inv; }
  store_out(st.o0, st.o1, (const bf16_t*)(p.ws + O_Z) + grow * 1024 + head * 64, (bf16_t*)(p.ws + OFF_H) + grow * 1024 + head * 64, h);
}

enum { PH_P0 = 0, PH_NORM, PH_G1, PH_E3, PH_E4, PH_E5, PH_O3, PH_O4, PH_OUT, PH_FINAL, PH_E4A };

typedef const Params __attribute__((address_space(4))) * KParamPtr;
DI void run_phase(char* smem, int ph, int layer, int vb, int nb) {
#if defined(__HIP_DEVICE_COMPILE__)
  KParamPtr kp = (KParamPtr)__builtin_amdgcn_kernarg_segment_ptr();
  asm volatile("" : "+s"(kp), "+s"(vb), "+s"(nb), "+s"(layer));
  Params p;
  __builtin_memcpy(&p, kp, sizeof(Params));
#else
  Params p{};
#endif
  const int li = layer >> 1;
  switch (ph) {
#if !defined(ONLY) || ONLY == 0
    case PH_P0: phase_p0(p, smem, vb, nb); break;
#endif
#if !defined(ONLY) || ONLY == 1
    case PH_NORM: phase_prep0(p, smem, vb, nb); break;
#endif
#if !defined(ONLY) || ONLY == 2
    case PH_G1: if (layer & 1) phase_g1_odd(p, smem, li, vb, nb); else phase_g1_even(p, smem, li, vb, nb); break;
#endif
#if !defined(ONLY) || ONLY == 3
    case PH_E3:
      if (nb > 256) {
        if (vb < 128) mlp1_tile(p, smem, li, vb);
        else for (int u = vb - 128; u < 1024; u += nb - 128) swa_unit(p, smem, li, u);
      } else {
        for (int u = vb; u < 128 + 1024; u += nb) { if (u < 128) mlp1_tile(p, smem, li, u); else swa_unit(p, smem, li, u - 128); }
      }
      break;
#endif
#if !defined(ONLY) || ONLY == 4
    case PH_E4:
      if (nb > 64) {
        if (vb < 32) mlp2_tile(p, smem, li, vb);
        else {
          const int W = nb - 32, vw = vb - 32;
          for (int r = 0; r * W < 1024; ++r) {
            const int k = r * W + ((r & 1) ? W - 1 - vw : vw);
            if (k < 1024) nsa_win_unit(p, smem, ((k & 15) << 6) | (63 - (k >> 4)));
          }
        }
      } else {
        for (int u = vb; u < 32; u += nb) mlp2_tile(p, smem, li, u);
        for (int k = vb; k < 1024; k += nb) nsa_win_unit(p, smem, ((k & 15) << 6) | (63 - (k >> 4)));
      }
      break;
#endif
#if !defined(ONLY) || ONLY == 5
    case PH_E5:
      for (int r = 0; r * nb < 1024; ++r) {
        const int idx = r * nb + ((r & 1) ? nb - 1 - vb : vb);
        if (idx >= 1024) continue;
        const int tt = 63 - (idx >> 4), bgi = idx & 15;
        nsa_unit(p, smem, (bgi << 6) | tt);
      }
      break;
#endif
#if !defined(ONLY) || ONLY == 6
    case PH_O3: for (int u = vb; u < 512; u += nb) kmean_unit(p, smem, u); break;
#endif
#if !defined(ONLY) || ONLY == 7
    case PH_O4:
      for (int r = 0; r * nb < 2048; ++r) {
        const int idx = r * nb + ((r & 1) ? nb - 1 - vb : vb);
        if (idx >= 2048) continue;
        const int chunk = 15 - (idx >> 7), bh = idx & 127;
        moba_unit(p, smem, li, (bh << 4) | chunk);
      }
      break;
#endif
#if !defined(ONLY) || ONLY == 8
    case PH_OUT: phase_out(p, smem, layer, vb, nb); break;
#endif
#if !defined(ONLY) || ONLY == 9
    case PH_FINAL: phase_final(p, vb, nb); break;
#endif
#if !defined(ONLY) || ONLY == 10
    case PH_E4A: break;
#endif
  }
}

constexpr int SMEM_BYTES = 55296;

template <int PH>
__global__ void __launch_bounds__(256, MINW) phase_kernel(Params p, int layer) {
  __shared__ __attribute__((aligned(16))) char smem[SMEM_BYTES];
  run_phase(smem, PH, layer, blockIdx.x, gridDim.x);
}

#define XB_TMO      128
#define XB_XCNT(j)  (256  + 64 * (j))
#define XB_XSUB(j)  (1280 + 64 * (j))
#define XB_XGEN(j)  (2304 + 64 * (j))
#define XB_TOP      3328
#define XB_TOPGEN   3392
#define XCD_BAR_WORDS 3456
#define XB_SPIN_CAP (1u << 18)
#define LAS __attribute__((address_space(3)))
DI unsigned xb_ld(unsigned* p) { return __hip_atomic_load(p, __ATOMIC_RELAXED, __HIP_MEMORY_SCOPE_AGENT); }
DI unsigned xb_add(unsigned* p, unsigned v) { return __hip_atomic_fetch_add(p, v, __ATOMIC_RELAXED, __HIP_MEMORY_SCOPE_AGENT); }
DI unsigned xb_xcc_id() { return (unsigned)__builtin_amdgcn_s_getreg((3 << 11) | 20) & 0xFu; }
#define XB_SPIN(cond, bar) do { unsigned _sp = 0; while (cond) { __builtin_amdgcn_s_sleep(1); \
    if ((++_sp & 255u) == 0u) { if (xb_ld(&(bar)[XB_TMO])) break; if (_sp > XB_SPIN_CAP) { atomicAdd(&(bar)[XB_TMO], 1u); break; } } } } while (0)
struct XcdBarrier { unsigned* bar; unsigned x; volatile LAS unsigned* st; };
DI XcdBarrier xcd_barrier_post(unsigned* bar, volatile LAS unsigned* st) {
  XcdBarrier b; b.bar = bar; b.x = xb_xcc_id(); b.st = st;
  if (threadIdx.x == 0) (void)xb_add(&bar[XB_XCNT(b.x)], 1u);
  return b;
}
DI void xcd_barrier_complete(unsigned* bar, unsigned x, unsigned& nloc, unsigned& nx) {
  const unsigned G = gridDim.x * gridDim.y * gridDim.z;
  unsigned sum, cnt, mine, sp = 0u;
  for (;;) {
    sum = 0u; cnt = 0u; mine = 0u;
#pragma unroll
    for (unsigned j = 0; j < 16; ++j) { const unsigned c = xb_ld(&bar[XB_XCNT(j)]); sum += c; cnt += (c > 0u) ? 1u : 0u; mine = (j == x) ? c : mine; }
    if (sum == G) break;
    __builtin_amdgcn_s_sleep(1);
    if ((++sp & 255u) == 0u) { if (xb_ld(&bar[XB_TMO])) break; if (sp > XB_SPIN_CAP) { atomicAdd(&bar[XB_TMO], 1u); break; } }
  }
  nloc = mine > 0u ? mine : 1u; nx = cnt > 0u ? cnt : 1u;
}
DI void xcd_barrier(const XcdBarrier& b) {
  asm volatile("s_waitcnt vmcnt(0)" ::: "memory");
  __syncthreads();
  if (threadIdx.x == 0) {
    unsigned* bar = b.bar;
    __builtin_amdgcn_s_waitcnt(0);
    unsigned nloc = b.st[0], nx = b.st[1];
    if (nloc == 0u) { xcd_barrier_complete(bar, b.x, nloc, nx); b.st[0] = nloc; b.st[1] = nx; }
    const unsigned old = xb_add(&bar[XB_XSUB(b.x)], 1u);
    const unsigned gen = old / nloc;
    if (old + 1u == (gen + 1u) * nloc) {
      __builtin_amdgcn_fence(__ATOMIC_RELEASE, "agent");
      asm volatile("s_waitcnt vmcnt(0)" ::: "memory");
      const unsigned og = xb_add(&bar[XB_TOP], 1u);
      const unsigned tg = og / nx;
      if (og + 1u == (tg + 1u) * nx) xb_add(&bar[XB_TOPGEN], 1u);
      else XB_SPIN(xb_ld(&bar[XB_TOPGEN]) == tg, bar);
      __builtin_amdgcn_fence(__ATOMIC_ACQUIRE, "agent");
      xb_add(&bar[XB_XGEN(b.x)], 1u);
      asm volatile("s_waitcnt vmcnt(0)" ::: "memory");
    } else {
      XB_SPIN(xb_ld(&bar[XB_XGEN(b.x)]) == gen, bar);
      __builtin_amdgcn_fence(__ATOMIC_ACQUIRE, "agent");
      asm volatile("s_waitcnt vmcnt(0)" ::: "memory");
    }
  }
  __syncthreads();
}

__global__ void __launch_bounds__(256, MINW) mega_kernel(Params p) {
  __shared__ __attribute__((aligned(16))) char smem[SMEM_BYTES];
  cg::grid_group grid = cg::this_grid();
  const int vb = blockIdx.x, nb = gridDim.x;
  __shared__ uint4 xb_words;
  unsigned* bar = (unsigned*)(p.ws + OFF_BAR);
  if (threadIdx.x == 0) xb_words = make_uint4(0u, 0u, 0u, 0u);
  if (vb == 0) for (int k = threadIdx.x; k < XCD_BAR_WORDS; k += 256) __hip_atomic_store(bar + k, 0u, __ATOMIC_RELAXED, __HIP_MEMORY_SCOPE_AGENT);
  __syncthreads();
  run_phase(smem, PH_P0, 0, vb, nb);
  if (PROBE_DUP & 2048) { __syncthreads(); run_phase(smem, PH_P0, 0, vb, nb); }
  grid.sync();
  const XcdBarrier xb = xcd_barrier_post(bar, (volatile LAS unsigned*)&xb_words);
#define GSYNC() xcd_barrier(xb)
  for (int layer = 0; layer < 4; ++layer) {
    if (layer == 0) { run_phase(smem, PH_NORM, layer, vb, nb); GSYNC(); if (PROBE_DUP & 4096) { run_phase(smem, PH_NORM, layer, vb, nb); GSYNC(); } }
    run_phase(smem, PH_G1, layer, vb, nb); GSYNC();
    if (PROBE_DUP & 1) { run_phase(smem, PH_G1, layer, vb, nb); GSYNC(); }
    if (layer & 1) {
      run_phase(smem, PH_O4, layer, vb, nb); GSYNC();
      if (PROBE_DUP & 4) { run_phase(smem, PH_O4, layer, vb, nb); GSYNC(); }
    } else {
      run_phase(smem, PH_E3, layer, vb, nb); GSYNC();
      if (PROBE_DUP & 8) { run_phase(smem, PH_E3, layer, vb, nb); GSYNC(); }
      run_phase(smem, PH_E4, layer, vb, nb); GSYNC();
      run_phase(smem, PH_E5, layer, vb, nb); GSYNC();
      if (PROBE_DUP & 2) { run_phase(smem, PH_E5, layer, vb, nb); GSYNC(); }
    }
    run_phase(smem, PH_OUT, layer, vb, nb); GSYNC();
    if ((PROBE_DUP & 32) && layer == 0) { for (int k = 0; k < 4; ++k) { run_phase(smem, PH_OUT, layer, vb, nb); GSYNC(); } }
  }
  if (PROBE_DUP & 64) { run_phase(smem, PH_P0, 0, vb, nb); GSYNC(); }
  if (PROBE_DUP & 128) { for (int k = 0; k < 20; ++k) GSYNC(); }
  if (PROBE_DUP & 256) { for (int k = 0; k < 4; ++k) { run_phase(smem, PH_O3, 1, vb, nb); GSYNC(); } }
#undef GSYNC
  run_phase(smem, PH_FINAL, 0, vb, nb);
}

extern "C" void kernel_launch(void* const* d_in, const int* in_sizes, int n_in, void* d_out, int out_size, void* d_ws, size_t ws_size,
                              hipStream_t stream) {
  Params p{};
  p.x = (const float*)d_in[0]; p.c = (const float*)d_in[1]; p.w_ada = (const float*)d_in[2]; p.b_ada = (const float*)d_in[3];
  p.norm_g = (const float*)d_in[4]; p.w_in_even = (const float*)d_in[5]; p.a_sinks = (const float*)d_in[6];
  p.pe_k = (const float*)d_in[7]; p.w1k = (const float*)d_in[8]; p.w2k = (const float*)d_in[9];
  p.pe_v = (const float*)d_in[10]; p.w1v = (const float*)d_in[11]; p.w2v = (const float*)d_in[12];
  p.w_out_even = (const float*)d_in[13]; p.w_in_odd = (const float*)d_in[14]; p.w_out_odd = (const float*)d_in[15];
  p.final_g = (const float*)d_in[16];
  p.out = (float*)d_out; p.ws = (char*)d_ws;
#if FUSED
  static int grid_blocks = 0;
  if (!grid_blocks) {
    int dev = 0, cus = 0, per_cu = 0;
    hipGetDevice(&dev);
    hipDeviceGetAttribute(&cus, hipDeviceAttributeMultiprocessorCount, dev);
    hipOccupancyMaxActiveBlocksPerMultiprocessor(&per_cu, mega_kernel, 256, 0);
    if (per_cu > 2) per_cu = 2;
    if (per_cu < 1) per_cu = 1;
    grid_blocks = cus * per_cu;
  }
  void* args[] = {&p};
  hipError_t e = hipLaunchCooperativeKernel((void*)mega_kernel, dim3(grid_blocks), dim3(256), args, 0, stream);
  if (e != hipSuccess) fprintf(stderr, "cooperative launch failed: %s (grid %d)\n", hipGetErrorString(e), grid_blocks);
#else
  const int G = 1024;
#define L(PH, layer) phase_kernel<PH><<<G, 256, 0, stream>>>(p, layer)
  L(PH_P0, 0);
  for (int layer = 0; layer < 4; ++layer) {
    if (layer == 0) L(PH_NORM, layer);
    L(PH_G1, layer); if (PROBE_DUP & 1) L(PH_G1, layer);
    if (layer & 1) { L(PH_O4, layer); if (PROBE_DUP & 4) L(PH_O4, layer); }
    else { L(PH_E3, layer); if (PROBE_DUP & 8) L(PH_E3, layer); L(PH_E4, layer); L(PH_E5, layer); if (PROBE_DUP & 2) L(PH_E5, layer); }
    L(PH_OUT, layer);
  }
  L(PH_FINAL, 0);
#undef L
#endif
}
```

```cpp
#include <hip/hip_runtime.h>
#include <hip/hip_cooperative_groups.h>
#include <stdint.h>
#include <stdio.h>
namespace cg = cooperative_groups;

#ifndef FUSED
#define FUSED 1
#endif
#ifndef PROBE_DUP
#define PROBE_DUP 0
#endif
#ifndef MINW
#define MINW 2
#endif

typedef unsigned short bf16_t;
typedef short bf16x8 __attribute__((ext_vector_type(8)));
typedef float f32x16 __attribute__((ext_vector_type(16)));
typedef unsigned u32x4 __attribute__((ext_vector_type(4)));
typedef unsigned u32x2 __attribute__((ext_vector_type(2)));
typedef float f32x4 __attribute__((ext_vector_type(4)));
#define DI __device__ __forceinline__
#define MFMA(a, b, c) __builtin_amdgcn_mfma_f32_32x32x16_bf16((a), (b), (c), 0, 0, 0)
#define NEG_INF (-__builtin_inff())

constexpr int S_ = 2048, T_ = 16384;
constexpr float SC2 = 0.125f * 1.44269504088896f;
constexpr float LOG2E = 1.44269504088896f;

constexpr size_t MBy = 1u << 20;
constexpr size_t OFF_H = 0;
constexpr size_t OFF_PROJ = 32 * MBy;
constexpr size_t OFF_WIE = 160 * MBy;
constexpr size_t OFF_WIO = 172 * MBy;
constexpr size_t OFF_WOE = 188 * MBy;
constexpr size_t OFF_WOO = 192 * MBy;
constexpr size_t OFF_W1 = 196 * MBy;
constexpr size_t OFF_W2 = 200 * MBy;
constexpr size_t OFF_ADA = 201 * MBy;
constexpr size_t OFF_ROPE = 204 * MBy;
constexpr size_t OFF_PEB = 205 * MBy;
constexpr size_t OFF_HID = 206 * MBy;
constexpr size_t OFF_KCMP = 208 * MBy;
constexpr size_t OFF_VCMPT = 208 * MBy + 512 * 1024;
constexpr size_t OFF_KMEAN = 209 * MBy;
constexpr size_t OFF_BAR = 210 * MBy;
constexpr size_t OFF_A2 = 212 * MBy;
constexpr size_t OFF_ROWSS = 245 * MBy;
constexpr size_t OFF_GG = 246 * MBy;
constexpr size_t OFF_BIAS = 247 * MBy;
constexpr size_t OFF_OWIN = OFF_PROJ + 112 * MBy;
constexpr size_t OFF_PART = OFF_PROJ + 96 * MBy;
constexpr size_t OFF_PEBF = OFF_PEB + 512 * 1024;
constexpr size_t E_QA = OFF_PROJ, E_ZA = OFF_PROJ + 16 * MBy, E_QB = OFF_PROJ + 32 * MBy, E_ZB = OFF_PROJ + 48 * MBy;
constexpr size_t E_KA = OFF_PROJ + 64 * MBy, E_VAT = OFF_PROJ + 66 * MBy, E_KC = OFF_PROJ + 68 * MBy, E_VC = OFF_PROJ + 72 * MBy;
constexpr size_t E_KS = OFF_PROJ + 76 * MBy, E_VST = OFF_PROJ + 80 * MBy, E_KW = OFF_PROJ + 84 * MBy, E_VWT = OFF_PROJ + 88 * MBy;
constexpr size_t E_GB = OFF_PROJ + 92 * MBy;
constexpr size_t O_Q = OFF_PROJ, O_K = OFF_PROJ + 32 * MBy, O_VT = OFF_PROJ + 64 * MBy, O_Z = OFF_PROJ + 96 * MBy;

struct Params {
  const float *x, *c, *w_ada, *b_ada, *norm_g, *w_in_even, *a_sinks, *pe_k, *w1k, *w2k, *pe_v, *w1v, *w2v, *w_out_even, *w_in_odd, *w_out_odd, *final_g;
  float* out;
  char* ws;
};

typedef __bf16 bf16v2 __attribute__((ext_vector_type(2)));
DI unsigned pk2(float lo, float hi) { bf16v2 v = {(__bf16)lo, (__bf16)hi}; return __builtin_bit_cast(unsigned, v); }
DI unsigned f2bf(float x) { return pk2(x, 0.f) & 0xffffu; }
DI float bf2f(unsigned b) { return __uint_as_float(b << 16); }
DI float bflo(unsigned u) { return __uint_as_float(u << 16); }
DI float bfhi(unsigned u) { return __uint_as_float(u & 0xffff0000u); }
DI int tidx() { int t = (int)__builtin_amdgcn_workitem_id_x(); asm volatile("" : "+v"(t)); return t; }
DI int crow(int r, int h) { return (r & 3) + 8 * (r >> 2) + 4 * h; }
DI float siluf(float z) { return z / (1.f + __expf(-z)); }
DI float ex2(float x) { return __builtin_amdgcn_exp2f(x); }

template <class ARow, class Epi>
DI void gemm_tiles(char* smem, const bf16_t* __restrict__ A, ARow arow, const bf16_t* __restrict__ Wt, int ldb, int K, int MT, int NT,
                   int vb, int nb, Epi epi, bool xcd_order = false) {
  bf16_t* As = (bf16_t*)smem;
  bf16_t* Bs = As + 128 * 72;
  const int tid = tidx(), lane = tid & 63, w = tid >> 6, wm = w >> 1, wn = w & 1;
  const int lr = tid >> 3, lc = (tid & 7) * 8;
  const int KT = K >> 6;
  const int i = lane & 31, h = lane >> 5;
  const bool xo = xcd_order && ((nb & 7) == 0) && ((MT & 7) == 0);
  const int t_start = xo ? (vb >> 3) : vb, t_step = xo ? (nb >> 3) : nb, t_total = xo ? (MT >> 3) * NT : MT * NT;
  for (int tile = t_start; tile < t_total; tile += t_step) {
    int tm, tn;
    if (xo) { const int gsz = 8 * NT, gid = tile / gsz, wi = tile - gid * gsz; tm = (vb & 7) * (MT >> 3) + gid * 8 + (wi & 7); tn = wi >> 3; }
    else { tm = tile / NT; tn = tile - tm * NT; }
    const bf16_t* ap0 = A + arow(tm * 128 + lr) + lc;
    const size_t astep = arow(tm * 128 + 32 + lr) - arow(tm * 128 + lr);
    const bf16_t* bp = Wt + (size_t)(tn * 256 + lr) * ldb + lc;
    const size_t bstep = (size_t)32 * ldb;
    u32x4 ra0, ra1, ra2, ra3, rb0, rb1, rb2, rb3, rb4, rb5, rb6, rb7;
#define GLOAD(ko)                                                                                         \
    ra0 = *(const u32x4*)(ap0 + (ko)); ra1 = *(const u32x4*)(ap0 + astep + (ko));                         \
    ra2 = *(const u32x4*)(ap0 + 2 * astep + (ko)); ra3 = *(const u32x4*)(ap0 + 3 * astep + (ko));         \
    rb0 = *(const u32x4*)(bp + (ko)); rb1 = *(const u32x4*)(bp + bstep + (ko));                           \
    rb2 = *(const u32x4*)(bp + 2 * bstep + (ko)); rb3 = *(const u32x4*)(bp + 3 * bstep + (ko));           \
    rb4 = *(const u32x4*)(bp + 4 * bstep + (ko)); rb5 = *(const u32x4*)(bp + 5 * bstep + (ko));           \
    rb6 = *(const u32x4*)(bp + 6 * bstep + (ko)); rb7 = *(const u32x4*)(bp + 7 * bstep + (ko));
    GLOAD(0)
    f32x16 acc[2][2][2];
#pragma unroll
    for (int a = 0; a < 2; ++a)
#pragma unroll
      for (int b = 0; b < 2; ++b)
#pragma unroll
        for (int c = 0; c < 2; ++c)
#pragma unroll
          for (int r = 0; r < 16; ++r) acc[a][b][c][r] = 0.f;
    for (int kt = 0; kt < KT; ++kt) {
      __syncthreads();
      *(u32x4*)(As + (lr) * 72 + lc) = ra0; *(u32x4*)(As + (32 + lr) * 72 + lc) = ra1;
      *(u32x4*)(As + (64 + lr) * 72 + lc) = ra2; *(u32x4*)(As + (96 + lr) * 72 + lc) = ra3;
      *(u32x4*)(Bs + (lr) * 72 + lc) = rb0; *(u32x4*)(Bs + (32 + lr) * 72 + lc) = rb1;
      *(u32x4*)(Bs + (64 + lr) * 72 + lc) = rb2; *(u32x4*)(Bs + (96 + lr) * 72 + lc) = rb3;
      *(u32x4*)(Bs + (128 + lr) * 72 + lc) = rb4; *(u32x4*)(Bs + (160 + lr) * 72 + lc) = rb5;
      *(u32x4*)(Bs + (192 + lr) * 72 + lc) = rb6; *(u32x4*)(Bs + (224 + lr) * 72 + lc) = rb7;
      __syncthreads();
      if (kt + 1 < KT) { const int ko = (kt + 1) * 64; GLOAD(ko) }
#pragma unroll
      for (int s = 0; s < 4; ++s) {
        bf16x8 af[2];
#pragma unroll
        for (int mi = 0; mi < 2; ++mi) af[mi] = *(const bf16x8*)(As + (wm * 64 + mi * 32 + i) * 72 + s * 16 + h * 8);
#pragma unroll
        for (int hf = 0; hf < 2; ++hf) {
          bf16x8 bfr[2];
#pragma unroll
          for (int ni = 0; ni < 2; ++ni) bfr[ni] = *(const bf16x8*)(Bs + (wn * 128 + hf * 64 + ni * 32 + i) * 72 + s * 16 + h * 8);
#pragma unroll
          for (int ni = 0; ni < 2; ++ni)
#pragma unroll
            for (int mi = 0; mi < 2; ++mi) acc[hf][mi][ni] = MFMA(bfr[ni], af[mi], acc[hf][mi][ni]);
        }
      }
    }
#undef GLOAD
    __syncthreads();
    epi(acc[0], tm * 128 + wm * 64, tn * 256 + wn * 128, lane, smem + w * 9216);
    epi(acc[1], tm * 128 + wm * 64, tn * 256 + wn * 128 + 64, lane, smem + w * 9216);
  }
}

DI void stage_flush(const bf16_t* img, bf16_t* dst, int ld, int lane) {
  asm volatile("" ::: "memory");
  const bf16_t* ip = img + (lane >> 3) * 72 + (lane & 7) * 8;
  bf16_t* dp = dst + (size_t)(lane >> 3) * ld + (lane & 7) * 8;
#pragma unroll
  for (int ps = 0; ps < 8; ++ps) {
    const u32x4 q = *(const u32x4*)(ip + ps * 8 * 72);
    *(u32x4*)dp = q;
    dp += 8 * ld;
  }
}
DI void st_rm(const f32x16 (&acc)[2][2], char* wsm, bf16_t* dst, int ld, int lane) {
  bf16_t* img = (bf16_t*)wsm;
  bf16_t* lp = img + (lane & 31) * 72 + 4 * (lane >> 5);
#pragma unroll
  for (int mi = 0; mi < 2; ++mi)
#pragma unroll
    for (int ni = 0; ni < 2; ++ni)
#pragma unroll
      for (int a = 0; a < 4; ++a) {
        uint2 o; o.x = pk2(acc[mi][ni][4 * a], acc[mi][ni][4 * a + 1]); o.y = pk2(acc[mi][ni][4 * a + 2], acc[mi][ni][4 * a + 3]);
        *(uint2*)(lp + (32 * mi * 72 + 32 * ni + 8 * a)) = o;
      }
  stage_flush(img, dst, ld, lane);
}
DI void st_rm_rope(const f32x16 (&acc)[2][2], char* wsm, bf16_t* dst, int ld, int lane, const float* cosT, const float* sinT, int pos0) {
  bf16_t* img = (bf16_t*)wsm;
  const int t = lane & 31, h = lane >> 5;
  bf16_t* lp = img + t * 72 + 4 * h;
  const float* cp = cosT + (pos0 + t) * 32 + 4 * h;
  const float* sp = sinT + (pos0 + t) * 32 + 4 * h;
#pragma unroll
  for (int mi = 0; mi < 2; ++mi)
#pragma unroll
    for (int a = 0; a < 4; ++a) {
      const float4 cs = *(const float4*)(cp + (32 * mi * 32 + 8 * a));
      const float4 sn = *(const float4*)(sp + (32 * mi * 32 + 8 * a));
      const float x10 = acc[mi][0][4 * a], x11 = acc[mi][0][4 * a + 1], x12 = acc[mi][0][4 * a + 2], x13 = acc[mi][0][4 * a + 3];
      const float x20 = acc[mi][1][4 * a], x21 = acc[mi][1][4 * a + 1], x22 = acc[mi][1][4 * a + 2], x23 = acc[mi][1][4 * a + 3];
      uint2 o1, o2;
      o1.x = pk2(x10 * cs.x - x20 * sn.x, x11 * cs.y - x21 * sn.y); o1.y = pk2(x12 * cs.z - x22 * sn.z, x13 * cs.w - x23 * sn.w);
      o2.x = pk2(x20 * cs.x + x10 * sn.x, x21 * cs.y + x11 * sn.y); o2.y = pk2(x22 * cs.z + x12 * sn.z, x23 * cs.w + x13 * sn.w);
      *(uint2*)(lp + (32 * mi * 72 + 8 * a)) = o1;
      *(uint2*)(lp + (32 * mi * 72 + 32 + 8 * a)) = o2;
    }
  stage_flush(img, dst, ld, lane);
}
DI void st_tr(const f32x16 (&acc)[2][2], char* wsm, bf16_t* dst, int ld, int lane, int ztok) {
  bf16_t* img = (bf16_t*)wsm;
  const int t = lane & 31, h = lane >> 5;
  bf16_t* lp = img + 4 * h * 72 + t;
#pragma unroll
  for (int mi = 0; mi < 2; ++mi) {
    const bool z = (32 * mi + t) == ztok;
#pragma unroll
    for (int ni = 0; ni < 2; ++ni)
#pragma unroll
      for (int r = 0; r < 16; ++r) {
        const float v = z ? 0.f : acc[mi][ni][r];
        lp[(32 * ni + (r & 3) + 8 * (r >> 2)) * 72 + 32 * mi] = (bf16_t)f2bf(v);
      }
  }
  stage_flush(img, dst, ld, lane);
}

DI f32x16 qk_scores(const bf16x8 (&qf)[4], const bf16_t* __restrict__ Kp, int kstride, int key0, int lane) {
  const int i = lane & 31, h = lane >> 5;
  const int a = i >> 3, hh = (i >> 2) & 1, b = i & 3;
  const int kperm = 16 * (a >> 1) + 8 * hh + 4 * (a & 1) + b;
  const bf16_t* kr = Kp + (size_t)(key0 + kperm) * kstride + 32 * h;
  bf16x8 kf[4];
#pragma unroll
  for (int s = 0; s < 4; ++s) kf[s] = *(const bf16x8*)(kr + 8 * s);
  f32x16 sa;
#pragma unroll
  for (int r = 0; r < 16; ++r) sa[r] = 0.f;
#pragma unroll
  for (int s = 0; s < 4; ++s) sa = MFMA(kf[s], qf[s], sa);
  return sa;
}
DI void load_kf(bf16x8 (&kf)[4], const bf16_t* __restrict__ Kp, int kstride, int key0, int lane) {
  const int i = lane & 31, h = lane >> 5;
  const int a = i >> 3, hh = (i >> 2) & 1, b = i & 3;
  const int kperm = 16 * (a >> 1) + 8 * hh + 4 * (a & 1) + b;
  const bf16_t* kr = Kp + (size_t)(key0 + kperm) * kstride + 32 * h;
#pragma unroll
  for (int s = 0; s < 4; ++s) kf[s] = *(const bf16x8*)(kr + 8 * s);
}
DI f32x16 qk_mfma(const bf16x8 (&kf)[4], const bf16x8 (&qf)[4]) {
  f32x16 sa;
#pragma unroll
  for (int r = 0; r < 16; ++r) sa[r] = 0.f;
#pragma unroll
  for (int s = 0; s < 4; ++s) sa = MFMA(kf[s], qf[s], sa);
  return sa;
}
DI void load_v(bf16x8 (&vf)[2][2], const bf16_t* __restrict__ Vp, int vstride, int key0, int lane) {
  const int i = lane & 31, h = lane >> 5;
#pragma unroll
  for (int dt = 0; dt < 2; ++dt)
#pragma unroll
    for (int s2 = 0; s2 < 2; ++s2) vf[dt][s2] = *(const bf16x8*)(Vp + (size_t)(32 * dt + i) * vstride + key0 + 16 * s2 + 8 * h);
}
DI void pack_p(const float (&p)[16], bf16x8 (&pf)[2]) {
#pragma unroll
  for (int s2 = 0; s2 < 2; ++s2) {
    union { bf16x8 v; unsigned u[4]; } t;
#pragma unroll
    for (int j = 0; j < 4; ++j) t.u[j] = pk2(p[8 * s2 + 2 * j], p[8 * s2 + 2 * j + 1]);
    pf[s2] = t.v;
  }
}
struct Att { float m, l; f32x16 o0, o1; };
DI void att_init(Att& st, float m0, float l0) {
  st.m = m0; st.l = l0;
#pragma unroll
  for (int r = 0; r < 16; ++r) { st.o0[r] = 0.f; st.o1[r] = 0.f; }
}
template <class MaskF>
DI void att_tile(Att& st, const bf16x8 (&qf)[4], const bf16_t* __restrict__ Kp, int kstride, const bf16_t* __restrict__ Vp, int vstride,
                 int key0, int lane, MaskF mask) {
  const int h = lane >> 5;
  f32x16 sa = qk_scores(qf, Kp, kstride, key0, lane);
  bf16x8 vf[2][2];
  load_v(vf, Vp, vstride, key0, lane);
  float p[16];
  float mx = NEG_INF;
#pragma unroll
  for (int r = 0; r < 16; ++r) {
    const int key = key0 + 16 * (r >> 3) + 8 * h + (r & 7);
    const float v = mask(key) ? sa[r] * SC2 : NEG_INF;
    p[r] = v; mx = fmaxf(mx, v);
  }
  mx = fmaxf(mx, __shfl_xor(mx, 32));
  const float mnew = fmaxf(st.m, mx);
  const float msafe = (mnew == NEG_INF) ? 0.f : mnew;
  const float alpha = ex2(st.m - msafe);
  float sum = 0.f;
#pragma unroll
  for (int r = 0; r < 16; ++r) { const float e = ex2(p[r] - msafe); p[r] = e; sum += e; }
  st.l = st.l * alpha + sum; st.m = mnew;
#pragma unroll
  for (int r = 0; r < 16; ++r) { st.o0[r] *= alpha; st.o1[r] *= alpha; }
  bf16x8 pf[2];
  pack_p(p, pf);
#pragma unroll
  for (int s2 = 0; s2 < 2; ++s2) { st.o0 = MFMA(vf[0][s2], pf[s2], st.o0); st.o1 = MFMA(vf[1][s2], pf[s2], st.o1); }
}
DI float att_invl(const Att& st) { const float l = st.l + __shfl_xor(st.l, 32); return l > 0.f ? 1.f / l : 0.f; }
DI void store_out(const f32x16& o0, const f32x16& o1, const bf16_t* __restrict__ zrow, bf16_t* __restrict__ orow, int h) {
  uint2 zz[8];
#pragma unroll
  for (int k = 0; k < 8; ++k) zz[k] = *(const uint2*)(zrow + 32 * (k >> 2) + 8 * (k & 3) + 4 * h);
#pragma unroll
  for (int dt = 0; dt < 2; ++dt)
#pragma unroll
    for (int a = 0; a < 4; ++a) {
      const int d = 32 * dt + 8 * a + 4 * h;
      const uint2 z2 = zz[dt * 4 + a];
      const f32x16& o = dt ? o1 : o0;
      const float r0 = o[4 * a] * siluf(bflo(z2.x)), r1 = o[4 * a + 1] * siluf(bfhi(z2.x));
      const float r2 = o[4 * a + 2] * siluf(bflo(z2.y)), r3 = o[4 * a + 3] * siluf(bfhi(z2.y));
      uint2 ov; ov.x = pk2(r0, r1); ov.y = pk2(r2, r3);
      *(uint2*)(orow + d) = ov;
    }
}

struct TrTile { const float* src; bf16_t* dst; int ldn, src_col0, nvalid, k0, ldk, n0; };
DI void transpose_pair(char* smem, const TrTile& a, const TrTile& b, bool two) {
  float* ta = (float*)smem;
  float* tb = ta + 64 * 65 + 16;
  const int tid = tidx();
  const int kr0 = tid >> 4, c4 = (tid & 15) * 4;
  float4 va[4], vb4[4];
#pragma unroll
  for (int p = 0; p < 4; ++p) {
    va[p] = make_float4(0.f, 0.f, 0.f, 0.f); vb4[p] = make_float4(0.f, 0.f, 0.f, 0.f);
    if (c4 < a.nvalid) va[p] = *(const float4*)(a.src + (size_t)(a.k0 + kr0 + 16 * p) * a.ldn + a.src_col0 + c4);
    if (two && c4 < b.nvalid) vb4[p] = *(const float4*)(b.src + (size_t)(b.k0 + kr0 + 16 * p) * b.ldn + b.src_col0 + c4);
  }
  __syncthreads();
#pragma unroll
  for (int p = 0; p < 4; ++p) {
    const int kr = kr0 + 16 * p;
    ta[kr * 65 + c4] = va[p].x; ta[kr * 65 + c4 + 1] = va[p].y; ta[kr * 65 + c4 + 2] = va[p].z; ta[kr * 65 + c4 + 3] = va[p].w;
    tb[kr * 65 + c4] = vb4[p].x; tb[kr * 65 + c4 + 1] = vb4[p].y; tb[kr * 65 + c4 + 2] = vb4[p].z; tb[kr * 65 + c4 + 3] = vb4[p].w;
  }
  __syncthreads();
  const int n = tid >> 2, ks = (tid & 3) * 16;
  {
    unsigned o[8];
#pragma unroll
    for (int j = 0; j < 8; ++j) o[j] = pk2(ta[(ks + 2 * j) * 65 + n], ta[(ks + 2 * j + 1) * 65 + n]);
    uint4* dp = (uint4*)(a.dst + (size_t)(a.n0 + n) * a.ldk + a.k0 + ks);
    dp[0] = make_uint4(o[0], o[1], o[2], o[3]);
    dp[1] = make_uint4(o[4], o[5], o[6], o[7]);
  }
  if (two) {
    unsigned o[8];
#pragma unroll
    for (int j = 0; j < 8; ++j) o[j] = pk2(tb[(ks + 2 * j) * 65 + n], tb[(ks + 2 * j + 1) * 65 + n]);
    uint4* dp = (uint4*)(b.dst + (size_t)(b.n0 + n) * b.ldk + b.k0 + ks);
    dp[0] = make_uint4(o[0], o[1], o[2], o[3]);
    dp[1] = make_uint4(o[4], o[5], o[6], o[7]);
  }
}
DI TrTile tr_tile(const Params& p, int t) {
  constexpr int T1 = 2 * 48 * 16, T2 = 2 * 64 * 16, T3 = 2 * 16 * 16, T4 = 2 * 16 * 16, T5 = 4 * 4 * 32;
  TrTile r;
  if (t < T1) {
    const int layer = t / 768, q = t % 768, nt = q >> 4, kt = q & 15;
    int src0, nvalid = 64;
    if (nt < 38) src0 = nt * 64; else if (nt < 46) src0 = 2456 + (nt - 38) * 64; else if (nt == 46) { src0 = 2432; nvalid = 24; } else { src0 = 0; nvalid = 0; }
    r.src = p.w_in_even + (size_t)layer * 1024 * 2968; r.ldn = 2968; r.src_col0 = src0; r.nvalid = nvalid; r.k0 = kt * 64;
    r.dst = (bf16_t*)(p.ws + OFF_WIE) + (size_t)layer * 3072 * 1024; r.ldk = 1024; r.n0 = nt * 64;
  } else if ((t -= T1) < T2) {
    const int layer = t / 1024, q = t % 1024, nt = q >> 4, kt = q & 15;
    r.src = p.w_in_odd + (size_t)layer * 1024 * 4096; r.ldn = 4096; r.src_col0 = nt * 64; r.nvalid = 64; r.k0 = kt * 64;
    r.dst = (bf16_t*)(p.ws + OFF_WIO) + (size_t)layer * 4096 * 1024; r.ldk = 1024; r.n0 = nt * 64;
  } else if ((t -= T2) < T3) {
    const int layer = t / 256, q = t % 256, nt = q >> 4, kt = q & 15;
    r.src = p.w_out_even + (size_t)layer * 1024 * 1024; r.ldn = 1024; r.src_col0 = nt * 64; r.nvalid = 64; r.k0 = kt * 64;
    r.dst = (bf16_t*)(p.ws + OFF_WOE) + (size_t)layer * 1024 * 1024; r.ldk = 1024; r.n0 = nt * 64;
  } else if ((t -= T3) < T4) {
    const int layer = t / 256, q = t % 256, nt = q >> 4, kt = q & 15;
    r.src = p.w_out_odd + (size_t)layer * 1024 * 1024; r.ldn = 1024; r.src_col0 = nt * 64; r.nvalid = 64; r.k0 = kt * 64;
    r.dst = (bf16_t*)(p.ws + OFF_WOO) + (size_t)layer * 1024 * 1024; r.ldk = 1024; r.n0 = nt * 64;
  } else if ((t -= T4) < T5) {
    const int lk = t / 128, q = t % 128, nt = q >> 5, kt = q & 31, layer = lk >> 1, kv = lk & 1;
    r.src = (kv ? p.w1v : p.w1k) + (size_t)layer * 2048 * 256; r.ldn = 256; r.src_col0 = nt * 64; r.nvalid = 64; r.k0 = kt * 64;
    r.dst = (bf16_t*)(p.ws + OFF_W1) + (size_t)lk * 256 * 2048; r.ldk = 2048; r.n0 = nt * 64;
  } else {
    t -= T5;
    const int lk = t / 16, q = t % 16, nt = q >> 2, kt = q & 3, layer = lk >> 1, kv = lk & 1;
    r.src = (kv ? p.w2v : p.w2k) + (size_t)layer * 256 * 64; r.ldn = 64; r.src_col0 = 0; r.nvalid = nt ? 0 : 64; r.k0 = kt * 64;
    r.dst = (bf16_t*)(p.ws + OFF_W2) + (size_t)lk * 256 * 256; r.ldk = 256; r.n0 = nt * 64;
  }
  return r;
}

DI void phase_p0(const Params& p, char* smem, int vb, int nb) {
  const int tid = tidx(), lane = tid & 63, w = tid >> 6;
  constexpr int N_ADA = 192, N_PEB = 64, N_ROPE = 256;
  constexpr int U0 = N_ADA + N_PEB + N_ROPE;
  constexpr int T1 = 2 * 48 * 16, T2 = 2 * 64 * 16, T3 = 2 * 16 * 16, T4 = 2 * 16 * 16, T5 = 4 * 4 * 32, T6 = 4 * 4 * 4;
  constexpr int NU = U0 + T1 + T2 + T3 + T4 + T5 + T6;
  for (int k = vb * 256 + tid; k < 4 * T_; k += nb * 256) ((float*)(p.ws + OFF_ROWSS))[T_ + k] = 0.f;
  for (int k = vb * 256 + tid; k < 2 * 65536; k += nb * 256) ((float*)(p.ws + OFF_KMEAN))[k] = 0.f;
  for (int u = vb; u < U0; u += nb) {
    if (u < N_ADA) {
      float* sc = (float*)smem;
      __syncthreads();
      for (int k = tid; k < 8192; k += 256) sc[k] = siluf(p.c[k]);
      __syncthreads();
      const int l = u / 48, eg = u % 48, e = eg * 64 + lane;
      float acc[8];
#pragma unroll
      for (int b = 0; b < 8; ++b) acc[b] = 0.f;
      const float* wp = p.w_ada + (size_t)l * 1024 * 3072 + e;
#pragma unroll 8
      for (int d0 = w * 256; d0 < w * 256 + 256; d0 += 4) {
        const float w0 = wp[(size_t)d0 * 3072], w1 = wp[(size_t)(d0 + 1) * 3072], w2 = wp[(size_t)(d0 + 2) * 3072], w3 = wp[(size_t)(d0 + 3) * 3072];
#pragma unroll
        for (int b = 0; b < 8; ++b) {
          const float4 cv = *(const float4*)(sc + b * 1024 + d0);
          acc[b] += cv.x * w0 + cv.y * w1 + cv.z * w2 + cv.w * w3;
        }
      }
      __syncthreads();
      float* red = (float*)smem;
#pragma unroll
      for (int b = 0; b < 8; ++b) red[(w * 8 + b) * 64 + lane] = acc[b];
      __syncthreads();
      for (int k = tid; k < 512; k += 256) {
        const int b = k >> 6, ln = k & 63;
        const float v = red[(0 * 8 + b) * 64 + ln] + red[(1 * 8 + b) * 64 + ln] + red[(2 * 8 + b) * 64 + ln] + red[(3 * 8 + b) * 64 + ln];
        const int ee = eg * 64 + ln;
        ((float*)(p.ws + OFF_ADA))[(size_t)(l * 8 + b) * 3072 + ee] = v + p.b_ada[l * 3072 + ee];
      }
    } else if (u < N_ADA + N_PEB) {
      const int uu = u - N_ADA, lk = uu >> 4, ch = uu & 15, layer = lk >> 1, kv = lk & 1;
      const float* pe = (kv ? p.pe_v : p.pe_k) + layer * 2048;
      const float* w1 = (kv ? p.w1v : p.w1k) + (size_t)layer * 2048 * 256;
      float acc = 0.f;
#pragma unroll 16
      for (int k = ch * 128; k < ch * 128 + 128; ++k) acc += pe[k] * w1[(size_t)k * 256 + tid];
      ((float*)(p.ws + OFF_PEB))[(lk * 16 + ch) * 256 + tid] = acc;
    } else if (u < U0) {
      const int idx = (u - N_ADA - N_PEB) * 256 + tid, pos = idx >> 5, j = idx & 31;
      const float inv = powf(10000.f, -(float)(2 * j) / 64.f);
      const float ang = (float)pos * inv;
      ((float*)(p.ws + OFF_ROPE))[idx] = cosf(ang);
      ((float*)(p.ws + OFF_ROPE))[65536 + idx] = sinf(ang);
    }
  }
  constexpr int TT = NU - U0;
  int t0i = vb, tsi = nb;
  if (nb >= 2 * N_ADA) { if (vb < N_ADA) return; t0i = vb - N_ADA; tsi = nb - N_ADA; }
  for (int t = t0i; t < TT; t += 2 * tsi) {
    const bool two = t + tsi < TT;
    const TrTile ta = tr_tile(p, t);
    const TrTile tb = tr_tile(p, two ? t + tsi : t);
    transpose_pair(smem, ta, tb, two);
  }
}

DI float wave_sum(float v) {
#pragma unroll
  for (int o = 32; o > 0; o >>= 1) v += __shfl_xor(v, o);
  return v;
}
DI void phase_prep0(const Params& p, char* smem, int vb, int nb) {
  const int tid = tidx(), lane = tid & 63, w = tid >> 6;
  const float* ada = (const float*)(p.ws + OFF_ADA);
  for (int u = vb; u < 448; u += nb) {
    int l, cg;
    if (u < 96) { l = 0; cg = u; } else if (u < 224) { l = 1; cg = u - 96; } else if (u < 320) { l = 2; cg = u - 224; } else { l = 3; cg = u - 320; }
    const bf16_t* Wt = (l & 1) ? (const bf16_t*)(p.ws + OFF_WIO) + (size_t)(l >> 1) * 4096 * 1024 : (const bf16_t*)(p.ws + OFF_WIE) + (size_t)(l >> 1) * 3072 * 1024;
    float* sh = (float*)smem;
    __syncthreads();
    for (int k = tid; k < 8192; k += 256) sh[k] = ada[(size_t)(l * 8 + (k >> 10)) * 3072 + (k & 1023)];
    __syncthreads();
    float* bias = (float*)(p.ws + OFF_BIAS) + (size_t)l * 8 * 4096;
    for (int j = 0; j < 8; ++j) {
      const int n = cg * 32 + w * 8 + j;
      const u32x4 q0 = *(const u32x4*)(Wt + (size_t)n * 1024 + lane * 16), q1 = *(const u32x4*)(Wt + (size_t)n * 1024 + lane * 16 + 8);
      float wv[16];
#pragma unroll
      for (int e = 0; e < 4; ++e) { wv[2 * e] = bflo(q0[e]); wv[2 * e + 1] = bfhi(q0[e]); wv[8 + 2 * e] = bflo(q1[e]); wv[8 + 2 * e + 1] = bfhi(q1[e]); }
#pragma unroll
      for (int b = 0; b < 8; ++b) {
        float a = 0.f;
#pragma unroll
        for (int e4 = 0; e4 < 4; ++e4) {
          const f32x4 sv = *(const f32x4*)(sh + b * 1024 + lane * 16 + 4 * e4);
          a += sv[0] * wv[4 * e4] + sv[1] * wv[4 * e4 + 1] + sv[2] * wv[4 * e4 + 2] + sv[3] * wv[4 * e4 + 3];
        }
        a = wave_sum(a);
        if (lane == 0) bias[b * 4096 + n] = a;
      }
    }
  }
  for (int k = vb * 256 + tid; k < 1024; k += nb * 256) {
    const float* pb = (const float*)(p.ws + OFF_PEB) + (k >> 8) * 16 * 256 + (k & 255);
    float a = 0.f;
#pragma unroll
    for (int ch = 0; ch < 16; ++ch) a += pb[ch * 256];
    ((float*)(p.ws + OFF_PEBF))[k] = a;
  }
  for (int k = vb * 256 + tid; k < 4 * 8 * 1024; k += nb * 256) {
    const int l = k >> 13, b = (k >> 10) & 7, c = k & 1023;
    ((float*)(p.ws + OFF_GG))[k] = p.norm_g[l * 1024 + c] * (1.f + ada[(size_t)(l * 8 + b) * 3072 + 1024 + c]);
  }
  bf16_t* A2 = (bf16_t*)(p.ws + OFF_A2);
  float* rowss = (float*)(p.ws + OFF_ROWSS);
  float4 gw[4];
#pragma unroll
  for (int k = 0; k < 4; ++k) gw[k] = *(const float4*)(p.norm_g + k * 256 + lane * 4);
  const int rstep = nb * 4;
  for (int row = vb * 4 + w; row < T_; row += 2 * rstep) {
    const int row1 = row + rstep;
    const bool has1 = row1 < T_;
    const float* xr0 = p.x + (size_t)row * 1024;
    const float* xr1 = p.x + (size_t)(has1 ? row1 : row) * 1024;
    float4 v0[4], v1[4], s0[4], s1[4];
#pragma unroll
    for (int k = 0; k < 4; ++k) { v0[k] = *(const float4*)(xr0 + k * 256 + lane * 4); v1[k] = *(const float4*)(xr1 + k * 256 + lane * 4); }
#pragma unroll
    for (int k = 0; k < 4; ++k) {
      s0[k] = *(const float4*)(ada + (size_t)(row >> 11) * 3072 + 1024 + k * 256 + lane * 4);
      s1[k] = *(const float4*)(ada + (size_t)((has1 ? row1 : row) >> 11) * 3072 + 1024 + k * 256 + lane * 4);
    }
    float ss0 = 0.f, ss1 = 0.f;
#pragma unroll
    for (int k = 0; k < 4; ++k) {
      ss0 += v0[k].x * v0[k].x + v0[k].y * v0[k].y + v0[k].z * v0[k].z + v0[k].w * v0[k].w;
      ss1 += v1[k].x * v1[k].x + v1[k].y * v1[k].y + v1[k].z * v1[k].z + v1[k].w * v1[k].w;
    }
    ss0 = wave_sum(ss0); ss1 = wave_sum(ss1);
    if (lane == 0) { rowss[row] = ss0; if (has1) rowss[row1] = ss1; }
#pragma unroll
    for (int k = 0; k < 4; ++k) {
      const int col = k * 256 + lane * 4;
      const float4 g = gw[k];
      uint2 o;
      o.x = pk2(v0[k].x * g.x * (1.f + s0[k].x), v0[k].y * g.y * (1.f + s0[k].y)); o.y = pk2(v0[k].z * g.z * (1.f + s0[k].z), v0[k].w * g.w * (1.f + s0[k].w));
      *(uint2*)(A2 + (size_t)row * 1024 + col) = o;
      if (has1) {
        o.x = pk2(v1[k].x * g.x * (1.f + s1[k].x), v1[k].y * g.y * (1.f + s1[k].y)); o.y = pk2(v1[k].z * g.z * (1.f + s1[k].z), v1[k].w * g.w * (1.f + s1[k].w));
        *(uint2*)(A2 + (size_t)row1 * 1024 + col) = o;
      }
    }
  }
}
DI void phase_final(const Params& p, int vb, int nb) {
  const int lane = tidx() & 63, w = tidx() >> 6;
  const float* rowss = (const float*)(p.ws + OFF_ROWSS) + 4 * T_;
  float4 gw[4];
#pragma unroll
  for (int k = 0; k < 4; ++k) gw[k] = *(const float4*)(p.final_g + k * 256 + lane * 4);
  const int rstep = nb * 4;
  for (int row = vb * 4 + w; row < T_; row += 4 * rstep) {
    f32x4 v[4][4];
    float rs[4];
#pragma unroll
    for (int q = 0; q < 4; ++q) {
      const int rq = row + q * rstep, rr = rq < T_ ? rq : row;
#pragma unroll
      for (int k = 0; k < 4; ++k) v[q][k] = *(const f32x4*)(p.out + (size_t)rr * 1024 + k * 256 + lane * 4);
      rs[q] = rsqrtf(rowss[rr] * (1.f / 1024.f) + 1e-6f);
    }
#pragma unroll
    for (int q = 0; q < 4; ++q) {
      const int rq = row + q * rstep;
      if (rq < T_) {
#pragma unroll
        for (int k = 0; k < 4; ++k) {
          const float4 g = gw[k];
          f32x4 o; o[0] = v[q][k][0] * rs[q] * g.x; o[1] = v[q][k][1] * rs[q] * g.y; o[2] = v[q][k][2] * rs[q] * g.z; o[3] = v[q][k][3] * rs[q] * g.w;
          *(f32x4*)(p.out + (size_t)rq * 1024 + k * 256 + lane * 4) = o;
        }
      }
    }
  }
}
DI void apply_rs_bias(f32x16 (&acc)[2][2], const float* rowss, const float* bias, int row0, int col0, int lane) {
  const int t = lane & 31, h = lane >> 5;
  const float rs0 = rsqrtf(rowss[row0 + t] * (1.f / 1024.f) + 1e-6f), rs1 = rsqrtf(rowss[row0 + 32 + t] * (1.f / 1024.f) + 1e-6f);
#pragma unroll
  for (int ni = 0; ni < 2; ++ni)
#pragma unroll
    for (int a = 0; a < 4; ++a) {
      const f32x4 bv = *(const f32x4*)(bias + col0 + 32 * ni + 8 * a + 4 * h);
#pragma unroll
      for (int bb = 0; bb < 4; ++bb) {
        acc[0][ni][4 * a + bb] = acc[0][ni][4 * a + bb] * rs0 + bv[bb];
        acc[1][ni][4 * a + bb] = acc[1][ni][4 * a + bb] * rs1 + bv[bb];
      }
    }
}

DI void phase_g1_even(const Params& p, char* smem, int li, int vb, int nb) {
  const bf16_t* H = (const bf16_t*)(p.ws + OFF_A2);
  const float* rowss = (const float*)(p.ws + OFF_ROWSS) + (size_t)(2 * li) * T_;
  const float* biasl = (const float*)(p.ws + OFF_BIAS) + (size_t)(2 * li) * 8 * 4096;
  const bf16_t* Wt = (const bf16_t*)(p.ws + OFF_WIE) + (size_t)li * 3072 * 1024;
  const float* cosT = (const float*)(p.ws + OFF_ROPE);
  const float* sinT = cosT + 65536;
  char* ws = p.ws;
  auto epi = [&](f32x16 (&acc)[2][2], int row0, int col0, int lane, char* wsm) {
    const int ct = col0 >> 6, b = row0 >> 11, s0 = row0 & 2047;
    if (ct >= 47) return;
    apply_rs_bias(acc, rowss, biasl + b * 4096, row0, col0, lane);
    int mode;
    bf16_t* dst; int ld;
    if (ct < 8) { mode = 1; dst = (bf16_t*)(ws + E_QA) + (size_t)row0 * 512 + ct * 64; ld = 512; }
    else if (ct == 8) { mode = 1; dst = (bf16_t*)(ws + E_KA) + (size_t)row0 * 64; ld = 64; }
    else if (ct == 9) { mode = 2; dst = (bf16_t*)(ws + E_VAT) + (size_t)b * 64 * 2048 + s0; ld = 2048; }
    else if (ct < 18) { mode = 0; dst = (bf16_t*)(ws + E_ZA) + (size_t)row0 * 512 + (ct - 10) * 64; ld = 512; }
    else if (ct < 26) { mode = 1; dst = (bf16_t*)(ws + E_QB) + (size_t)row0 * 512 + (ct - 18) * 64; ld = 512; }
    else if (ct < 28) { mode = 1; dst = (bf16_t*)(ws + E_KC) + ((size_t)(b * 2 + ct - 26) * 2048 + s0) * 64; ld = 64; }
    else if (ct < 30) { mode = 0; dst = (bf16_t*)(ws + E_VC) + ((size_t)(b * 2 + ct - 28) * 2048 + s0) * 64; ld = 64; }
    else if (ct < 32) { mode = 1; dst = (bf16_t*)(ws + E_KS) + (size_t)row0 * 128 + (ct - 30) * 64; ld = 128; }
    else if (ct < 34) { mode = 2; dst = (bf16_t*)(ws + E_VST) + (size_t)(b * 2 + ct - 32) * 64 * 2048 + s0; ld = 2048; }
    else if (ct < 36) { mode = 1; dst = (bf16_t*)(ws + E_KW) + (size_t)row0 * 128 + (ct - 34) * 64; ld = 128; }
    else if (ct < 38) { mode = 2; dst = (bf16_t*)(ws + E_VWT) + (size_t)(b * 2 + ct - 36) * 64 * 2048 + s0; ld = 2048; }
    else if (ct < 46) { mode = 0; dst = (bf16_t*)(ws + E_ZB) + (size_t)row0 * 512 + (ct - 38) * 64; ld = 512; }
    else if (ct == 46) { mode = 3; dst = nullptr; ld = 0; }
    else { mode = 4; dst = nullptr; ld = 0; }
    if (mode == 0) st_rm(acc, wsm, dst, ld, lane);
    else if (mode == 1) st_rm_rope(acc, wsm, dst, ld, lane, cosT, sinT, s0);
    else if (mode == 2) st_tr(acc, wsm, dst, ld, lane, -1);
    else if (mode == 3) {
      float* GB = (float*)(ws + E_GB);
      const int t = lane & 31, h = lane >> 5;
#pragma unroll
      for (int mi = 0; mi < 2; ++mi)
#pragma unroll
        for (int a = 0; a < 3; ++a) {
          float4 o; o.x = acc[mi][0][4 * a]; o.y = acc[mi][0][4 * a + 1]; o.z = acc[mi][0][4 * a + 2]; o.w = acc[mi][0][4 * a + 3];
          *(float4*)(GB + (size_t)(row0 + 32 * mi + t) * 24 + 8 * a + 4 * h) = o;
        }
    }
  };
  gemm_tiles(smem, H, [](int r) { return (size_t)r * 1024; }, Wt, 1024, 1024, 128, 12, vb, nb, epi, true);
}
DI void phase_g1_odd(const Params& p, char* smem, int li, int vb, int nb) {
  const bf16_t* H = (const bf16_t*)(p.ws + OFF_A2);
  float* kmean = (float*)(p.ws + OFF_KMEAN) + (size_t)li * 65536;
  const float* rowss = (const float*)(p.ws + OFF_ROWSS) + (size_t)(2 * li + 1) * T_;
  const float* biasl = (const float*)(p.ws + OFF_BIAS) + (size_t)(2 * li + 1) * 8 * 4096;
  const bf16_t* Wt = (const bf16_t*)(p.ws + OFF_WIO) + (size_t)li * 4096 * 1024;
  const float* cosT = (const float*)(p.ws + OFF_ROPE);
  const float* sinT = cosT + 65536;
  char* ws = p.ws;
  auto epi = [&](f32x16 (&acc)[2][2], int row0, int col0, int lane, char* wsm) {
    const int ct = col0 >> 6, b = row0 >> 11, s0 = row0 & 2047;
    apply_rs_bias(acc, rowss, biasl + b * 4096, row0, col0, lane);
    if (ct < 32) {
      st_rm_rope(acc, wsm, (bf16_t*)(ws + (ct < 16 ? O_Q : O_K)) + (size_t)row0 * 1024 + (ct & 15) * 64, 1024, lane, cosT, sinT, s0);
      if (ct >= 16) {
        const bf16_t* img = (const bf16_t*)wsm + lane;
        float cs = 0.f;
#pragma unroll 16
        for (int r = 0; r < 64; ++r) cs += bf2f(img[r * 72]);
        atomicAdd(kmean + (((size_t)b * 16 + (ct - 16)) * 8 + (s0 >> 8)) * 64 + lane, cs * (1.f / 256.f));
      }
    }
    else if (ct < 48) st_tr(acc, wsm, (bf16_t*)(ws + O_VT) + (size_t)(b * 16 + ct - 32) * 64 * 2048 + s0, 2048, lane, -1);
    else st_rm(acc, wsm, (bf16_t*)(ws + O_Z) + (size_t)row0 * 1024 + (ct - 48) * 64, 1024, lane);
  };
  gemm_tiles(smem, H, [](int r) { return (size_t)r * 1024; }, Wt, 1024, 1024, 128, 16, vb, nb, epi, true);
}
DI void phase_out(const Params& p, char* smem, int layer, int vb, int nb) {
  const bf16_t* AO = (const bf16_t*)(p.ws + OFF_H);
  const bf16_t* Wt = (const bf16_t*)(p.ws + ((layer & 1) ? OFF_WOO : OFF_WOE)) + (size_t)(layer >> 1) * 1024 * 1024;
  const float* xin = layer == 0 ? p.x : p.out;
  float* xo = p.out;
  const float* ada = (const float*)(p.ws + OFF_ADA);
  bf16_t* A2 = (bf16_t*)(p.ws + OFF_A2);
  float* rowss = (float*)(p.ws + OFF_ROWSS) + (size_t)(layer + 1) * T_;
  const float* ggn = (const float*)(p.ws + OFF_GG) + (size_t)(layer < 3 ? layer + 1 : 3) * 8 * 1024;
  auto epi = [&](const f32x16 (&acc)[2][2], int row0, int col0, int lane, char* wsm) {
    const int t = lane & 31, h = lane >> 5, b = row0 >> 11;
    float* img = (float*)wsm;
    const int rr = lane >> 4, cc = (lane & 15) * 4;
    const f32x4 gate = *(const f32x4*)(ada + (size_t)(layer * 8 + b) * 3072 + 2048 + col0 + cc);
    const f32x4 gg = *(const f32x4*)(ggn + b * 1024 + col0 + cc);
#pragma unroll
    for (int mi = 0; mi < 2; ++mi) {
#pragma unroll
      for (int ni = 0; ni < 2; ++ni)
#pragma unroll
        for (int a = 0; a < 4; ++a) {
          f32x4 o; o[0] = acc[mi][ni][4 * a]; o[1] = acc[mi][ni][4 * a + 1]; o[2] = acc[mi][ni][4 * a + 2]; o[3] = acc[mi][ni][4 * a + 3];
          *(f32x4*)(img + t * 68 + 32 * ni + 8 * a + 4 * h) = o;
        }
      asm volatile("" ::: "memory");
      f32x4 xv[8];
#pragma unroll
      for (int ps = 0; ps < 8; ++ps) xv[ps] = *(const f32x4*)(xin + (size_t)(row0 + 32 * mi + ps * 4 + rr) * 1024 + col0 + cc);
#pragma unroll
      for (int ps = 0; ps < 8; ++ps) {
        const int row = ps * 4 + rr;
        const f32x4 y = *(const f32x4*)(img + row * 68 + cc);
        const size_t o = (size_t)(row0 + 32 * mi + row) * 1024 + col0 + cc;
        const f32x4 xn = xv[ps] + gate * y;
        *(f32x4*)(xo + o) = xn;
        if (layer < 3) { uint2 a2; a2.x = pk2(xn[0] * gg[0], xn[1] * gg[1]); a2.y = pk2(xn[2] * gg[2], xn[3] * gg[3]); *(uint2*)(A2 + o) = a2; }
        float sq = xn[0] * xn[0] + xn[1] * xn[1] + xn[2] * xn[2] + xn[3] * xn[3];
        sq += __shfl_xor(sq, 1); sq += __shfl_xor(sq, 2); sq += __shfl_xor(sq, 4); sq += __shfl_xor(sq, 8);
        if ((lane & 15) == 0) atomicAdd(rowss + row0 + 32 * mi + row, sq);
      }
      asm volatile("" ::: "memory");
    }
  };
  gemm_tiles(smem, AO, [](int r) { return (size_t)r * 1024; }, Wt, 1024, 1024, 128, 4, vb, nb, epi, true);
}

DI void mlp1_tile(const Params& p, char* smem, int li, int t) {
  const int ks = t & 3, kv = t >> 6, tt = (t >> 2) & 15, lk = li * 2 + kv;
  const bf16_t* A = (const bf16_t*)(p.ws + (kv ? E_VC : E_KC)) + ks * 512;
  const bf16_t* Wt = (const bf16_t*)(p.ws + OFF_W1) + (size_t)lk * 256 * 2048 + ks * 512;
  float* part = (float*)(p.ws + OFF_PART) + (size_t)(ks * 2 + kv) * 2048 * 256;
  auto epi = [&](const f32x16 (&acc)[2][2], int row0, int col0, int lane, char* wsm) {
    const int t2 = lane & 31, h = lane >> 5;
#pragma unroll
    for (int mi = 0; mi < 2; ++mi)
#pragma unroll
      for (int ni = 0; ni < 2; ++ni)
#pragma unroll
        for (int a = 0; a < 4; ++a) {
          f32x4 o; o[0] = acc[mi][ni][4 * a]; o[1] = acc[mi][ni][4 * a + 1]; o[2] = acc[mi][ni][4 * a + 2]; o[3] = acc[mi][ni][4 * a + 3];
          *(f32x4*)(part + (size_t)(row0 + 32 * mi + t2) * 256 + col0 + 32 * ni + 8 * a + 4 * h) = o;
        }
  };
  gemm_tiles(smem, A, [](int r) { return (size_t)(r >> 7) * 131072 + (size_t)(r & 127) * 1024; }, Wt, 2048, 512, 16, 1, tt, 1 << 30, epi);
}
DI void hid_rows(const Params& p, int li, int kv, int row_base) {
  const float* part = (const float*)(p.ws + OFF_PART);
  bf16_t* Hd = (bf16_t*)(p.ws + OFF_HID);
  const int base_idx = (kv * 2048 + row_base) * 64;
  constexpr size_t PSTR = (size_t)2 * 2048 * 256;
  const float* pebf = (const float*)(p.ws + OFF_PEBF) + (li * 2 + kv) * 256;
  for (int j0 = tidx(); j0 < 128 * 64; j0 += 4 * 256) {
    f32x4 pv[4][5];
#pragma unroll
    for (int q = 0; q < 4; ++q) {
      const int idx = base_idx + j0 + q * 256;
      const size_t e = (size_t)idx * 4;
#pragma unroll
      for (int k = 0; k < 4; ++k) pv[q][k] = *(const f32x4*)(part + k * PSTR + e);
      pv[q][4] = *(const f32x4*)(pebf + (idx & 63) * 4);
    }
#pragma unroll
    for (int q = 0; q < 4; ++q) {
      const int idx = base_idx + j0 + q * 256;
      const size_t e = (size_t)idx * 4;
      const f32x4 v = (pv[q][0] + pv[q][1]) + (pv[q][2] + pv[q][3]) + pv[q][4];
      float g[4];
#pragma unroll
      for (int bb = 0; bb < 4; ++bb) {
        const float xv = v[bb];
        const float uu = 0.7978845608028654f * (xv + 0.044715f * xv * xv * xv);
        const float th = 1.f - 2.f / (__expf(2.f * uu) + 1.f);
        g[bb] = 0.5f * xv * (1.f + th);
      }
      uint2 o; o.x = pk2(g[0], g[1]); o.y = pk2(g[2], g[3]);
      *(uint2*)(Hd + e) = o;
    }
  }
  asm volatile("s_waitcnt vmcnt(0)" ::: "memory");
  __syncthreads();
}
DI void mlp2_tile(const Params& p, char* smem, int li, int t) {
  const int kv = t >> 4, tt = t & 15, lk = li * 2 + kv;
  hid_rows(p, li, kv, tt * 128);
  const bf16_t* A = (const bf16_t*)(p.ws + OFF_HID) + (size_t)kv * 2048 * 256;
  const bf16_t* Wt = (const bf16_t*)(p.ws + OFF_W2) + (size_t)lk * 256 * 256;
  bf16_t* KC = (bf16_t*)(p.ws + OFF_KCMP);
  bf16_t* VT = (bf16_t*)(p.ws + OFF_VCMPT);
  auto epi = [&](const f32x16 (&acc)[2][2], int row0, int col0, int lane, char* wsm) {
    if (col0 != 0) return;
    const int bg = row0 >> 7, c0 = row0 & 127;
    if (kv == 0) {
      f32x16 g[2][2];
      const int t = lane & 31;
#pragma unroll
      for (int mi = 0; mi < 2; ++mi)
#pragma unroll
        for (int ni = 0; ni < 2; ++ni)
#pragma unroll
          for (int r = 0; r < 16; ++r) g[mi][ni][r] = (c0 + 32 * mi + t == 127) ? 0.f : acc[mi][ni][r];
      st_rm(g, wsm, KC + (size_t)row0 * 64, 64, lane);
    } else {
      st_tr(acc, wsm, VT + (size_t)bg * 64 * 128 + c0, 128, lane, 127 - c0);
    }
  };
  gemm_tiles(smem, A, [](int r) { return (size_t)r * 256; }, Wt, 256, 256, 16, 1, tt, 1 << 30, epi);
}

constexpr float LAZY = 6.f;
#define TILE_ISSUE(key0_)                                                          \
  do {                                                                             \
    const int kk_ = (key0_);                                                       \
    gk0 = *(const u32x4*)(K + (size_t)(kk_ + ldr) * kstride + ldc);                \
    gk1 = *(const u32x4*)(K + (size_t)(kk_ + ldr + 32) * kstride + ldc);           \
    gv0 = *(const u32x4*)(V + (size_t)(ldr) * vstride + kk_ + ldc);                \
    gv1 = *(const u32x4*)(V + (size_t)(ldr + 32) * vstride + kk_ + ldc);           \
  } while (0)
#define TILE_STORE(Kb_)                                                            \
  do {                                                                             \
    bf16_t* kb_ = (Kb_);                                                           \
    *(u32x4*)(kb_ + ldr * 72 + ldc) = gk0;                                         \
    *(u32x4*)(kb_ + (ldr + 32) * 72 + ldc) = gk1;                                  \
    *(u32x4*)(kb_ + 64 * 72 + ldr * 72 + ldc) = gv0;                               \
    *(u32x4*)(kb_ + 64 * 72 + (ldr + 32) * 72 + ldc) = gv1;                        \
  } while (0)
template <int MODE, class MF>
DI void att_tile64(Att& st, const bf16x8 (&qf)[4], const bf16_t* Kb, const bf16_t* Vb, int lane, const MF& mf) {
  const int i = lane & 31, h = lane >> 5;
  const int a = i >> 3, hh = (i >> 2) & 1, b = i & 3;
  const int kperm = 16 * (a >> 1) + 8 * hh + 4 * (a & 1) + b;
  f32x16 sa[2];
#pragma unroll
  for (int sub = 0; sub < 2; ++sub) {
#pragma unroll
    for (int r = 0; r < 16; ++r) sa[sub][r] = 0.f;
#pragma unroll
    for (int s = 0; s < 4; ++s) {
      const bf16x8 kf = *(const bf16x8*)(Kb + (32 * sub + kperm) * 72 + 32 * h + 8 * s);
      sa[sub] = MFMA(kf, qf[s], sa[sub]);
    }
  }
  float mx = NEG_INF;
#pragma unroll
  for (int sub = 0; sub < 2; ++sub)
#pragma unroll
    for (int r = 0; r < 16; ++r) {
      if (MODE == 2 || MODE == 4) {
        const int c = 32 * sub + 16 * (r >> 3) + (r & 7);
        bool ok = c <= mf.lim_hi;
        if (MODE == 4) ok = ok && (c > mf.lim_lo);
        if (!ok) sa[sub][r] = NEG_INF;
      }
      mx = fmaxf(mx, sa[sub][r]);
    }
  mx = fmaxf(mx, __shfl_xor(mx, 32)) * SC2;
  if (MODE == 3) mx = mf.on ? mx : NEG_INF;
  const bool upd = mx > st.m + LAZY;
  if (__any(upd)) {
    const float mnew = upd ? mx : st.m;
    const float alpha = upd ? ex2(st.m - mnew) : 1.f;
    st.m = mnew; st.l *= alpha;
#pragma unroll
    for (int r = 0; r < 16; ++r) { st.o0[r] *= alpha; st.o1[r] *= alpha; }
  }
  float nm = (st.m == NEG_INF) ? 0.f : -st.m;
  if (MODE == 3) nm = mf.on ? nm : NEG_INF;
  float sum = 0.f;
#pragma unroll
  for (int sub = 0; sub < 2; ++sub)
#pragma unroll
    for (int r = 0; r < 16; ++r) { const float e = ex2(__builtin_fmaf(sa[sub][r], SC2, nm)); sa[sub][r] = e; sum += e; }
  st.l += sum;
#pragma unroll
  for (int sub = 0; sub < 2; ++sub)
#pragma unroll
    for (int s2 = 0; s2 < 2; ++s2) {
      union { bf16x8 v; unsigned u[4]; } t;
#pragma unroll
      for (int j = 0; j < 4; ++j) t.u[j] = pk2(sa[sub][8 * s2 + 2 * j], sa[sub][8 * s2 + 2 * j + 1]);
      const bf16x8 vf0 = *(const bf16x8*)(Vb + (i) * 72 + 32 * sub + 16 * s2 + 8 * h);
      const bf16x8 vf1 = *(const bf16x8*)(Vb + (32 + i) * 72 + 32 * sub + 16 * s2 + 8 * h);
      st.o0 = MFMA(vf0, t.v, st.o0);
      st.o1 = MFMA(vf1, t.v, st.o1);
    }
}
template <class MF>
DI void att_stream(char* smem, Att& st, const bf16x8 (&qf)[4], const bf16_t* __restrict__ K, int kstride, const bf16_t* __restrict__ V, int vstride,
                   int tlo, int thi, int lane, MF& mf) {
  bf16_t* base = (bf16_t*)smem;
  u32x4 gk0, gk1, gv0, gv1;
  const int ldt = tidx(), ldr = ldt >> 3, ldc = (ldt & 7) * 8;
  __syncthreads();
  TILE_ISSUE(tlo * 64);
  TILE_STORE(base);
  TILE_ISSUE(((tlo + 1 <= thi) ? tlo + 1 : tlo) * 64);
  __syncthreads();
  for (int t = tlo; t <= thi; ++t) {
    const int cur = (t - tlo) & 1;
    bf16_t* Kb = base + cur * (2 * 64 * 72);
    bf16_t* Kn = base + (cur ^ 1) * (2 * 64 * 72);
    if (t + 1 <= thi) TILE_STORE(Kn);
    if (t + 2 <= thi) TILE_ISSUE((t + 2) * 64);
    const int c = mf.cls(t * 64);
    if (c == 1) att_tile64<1>(st, qf, Kb, Kb + 64 * 72, lane, mf);
    else if (c == 2) att_tile64<2>(st, qf, Kb, Kb + 64 * 72, lane, mf);
    else if (c == 3) att_tile64<3>(st, qf, Kb, Kb + 64 * 72, lane, mf);
    else if (c == 4) att_tile64<4>(st, qf, Kb, Kb + 64 * 72, lane, mf);
    __syncthreads();
  }
}
struct MaskWin {
  int token, t0, win, h8; int lim_hi, lim_lo; bool on;
  DI int cls(int key0) {
    if (key0 > t0 + 31 || key0 + 63 <= t0 - win) return 0;
    const bool lo_ok = key0 > t0 + 31 - win;
    if (key0 + 63 <= t0 && lo_ok) return 1;
    lim_hi = token - key0 - h8; lim_lo = token - win - key0 - h8;
    return lo_ok ? 2 : 4;
  }
};
struct MaskSel {
  unsigned sel; int token, t0, h8; int lim_hi, lim_lo; bool on;
  DI int cls(int key0) {
    on = (sel >> (key0 >> 6)) & 1u;
    const unsigned long long bal = __ballot(on);
    if (bal == 0ull || key0 > t0 + 31) return 0;
    if (key0 + 63 <= t0) return bal == ~0ull ? 1 : 3;
    lim_hi = on ? token - key0 - h8 : -1;
    return 2;
  }
};
struct MaskMoba {
  unsigned sel; int token, t0, ob, h8; int lim_hi, lim_lo; bool on;
  DI int cls(int key0) {
    if (key0 < ob * 256) {
      on = (sel >> (key0 >> 8)) & 1u;
      const unsigned long long bal = __ballot(on);
      return bal == 0ull ? 0 : (bal == ~0ull ? 1 : 3);
    }
    if (key0 > t0 + 31) return 0;
    if (key0 + 63 <= t0) return 1;
    lim_hi = token - key0 - h8;
    return 2;
  }
};

DI void swa_unit(const Params& p, char* smem, int li, int u) {
  const int lane = tidx() & 63, w = tidx() >> 6, i = lane & 31, h = lane >> 5;
  const int b = u >> 7, tt = (u >> 1) & 63, hg = u & 1, head = hg * 4 + w, t0 = tt * 32, token = t0 + i;
  const size_t grow = (size_t)b * S_ + token;
  const bf16_t* qp = (const bf16_t*)(p.ws + E_QA) + grow * 512 + head * 64 + 32 * h;
  bf16x8 qf[4];
#pragma unroll
  for (int s = 0; s < 4; ++s) qf[s] = *(const bf16x8*)(qp + 8 * s);
  const bf16_t* Kp = (const bf16_t*)(p.ws + E_KA) + (size_t)b * S_ * 64;
  const bf16_t* Vp = (const bf16_t*)(p.ws + E_VAT) + (size_t)b * 64 * S_;
  Att st;
  att_init(st, p.a_sinks[li * 8 + head] * LOG2E, h == 0 ? 1.f : 0.f);
  int k0 = t0 - 128; if (k0 < 0) k0 = 0;
  MaskWin mf{token, t0, 128, 8 * h, 0, 0, true};
  att_stream(smem, st, qf, Kp, 64, Vp, S_, k0 >> 6, t0 >> 6, lane, mf);
  const float inv = att_invl(st);
#pragma unroll
  for (int r = 0; r < 16; ++r) { st.o0[r] *= inv; st.o1[r] *= inv; }
  store_out(st.o0, st.o1, (const bf16_t*)(p.ws + E_ZA) + grow * 512 + head * 64, (bf16_t*)(p.ws + OFF_H) + grow * 1024 + head * 64, h);
}

DI void nsa_win_unit(const Params& p, char* smem, int u) {
  const int tid = tidx(), lane = tid & 63, w = tid >> 6, i = lane & 31, h = lane >> 5;
  const int b = u >> 7, g = (u >> 6) & 1, tt = u & 63, t0 = tt * 32, token = t0 + i, head = g * 4 + w, bg = b * 2 + g;
  const size_t grow = (size_t)b * S_ + token;
  const bf16_t* qp = (const bf16_t*)(p.ws + E_QB) + grow * 512 + head * 64 + 32 * h;
  bf16x8 qf[4];
#pragma unroll
  for (int s = 0; s < 4; ++s) qf[s] = *(const bf16x8*)(qp + 8 * s);
  const float gl2 = ((const float*)(p.ws + E_GB))[grow * 24 + head * 3 + 2];
  const float g2 = 1.f / (1.f + __expf(-gl2));
  const bf16_t* Kp = (const bf16_t*)(p.ws + E_KW) + (size_t)b * S_ * 128 + g * 64;
  const bf16_t* Vp = (const bf16_t*)(p.ws + E_VWT) + (size_t)bg * 64 * S_;
  Att st; att_init(st, NEG_INF, 0.f);
  int k0 = t0 - 512; if (k0 < 0) k0 = 0;
  MaskWin mf{token, t0, 512, 8 * h, 0, 0, true};
  att_stream(smem, st, qf, Kp, 128, Vp, S_, k0 >> 6, t0 >> 6, lane, mf);
  const float inv = att_invl(st) * g2;
  bf16_t* ow = (bf16_t*)(p.ws + OFF_OWIN) + grow * 512 + head * 64 + 4 * h;
#pragma unroll
  for (int a = 0; a < 4; ++a) {
    u32x2 o0, o1;
    o0[0] = pk2(st.o0[4 * a] * inv, st.o0[4 * a + 1] * inv); o0[1] = pk2(st.o0[4 * a + 2] * inv, st.o0[4 * a + 3] * inv);
    o1[0] = pk2(st.o1[4 * a] * inv, st.o1[4 * a + 1] * inv); o1[1] = pk2(st.o1[4 * a + 2] * inv, st.o1[4 * a + 3] * inv);
    *(u32x2*)(ow + 8 * a) = o0;
    *(u32x2*)(ow + 32 + 8 * a) = o1;
  }
}
DI void nsa_unit(const Params& p, char* smem, int u) {
  float* imp_s = (float*)smem;
  float* sc_s = imp_s + 4096;
  unsigned* sel_s = (unsigned*)(sc_s + 32 * 33);
  unsigned* uni_s = sel_s + 32;
  const int tid = tidx(), lane = tid & 63, w = tid >> 6, i = lane & 31, h = lane >> 5;
  const int b = u >> 7, g = (u >> 6) & 1, tt = u & 63, t0 = tt * 32, token = t0 + i, head = g * 4 + w, bg = b * 2 + g;
  const size_t grow = (size_t)b * S_ + token;
  __syncthreads();
  for (int k = tid; k < 4096; k += 256) imp_s[k] = 0.f;
  if (tid == 0) *uni_s = 0u;
  __syncthreads();
  const bf16_t* qp = (const bf16_t*)(p.ws + E_QB) + grow * 512 + head * 64 + 32 * h;
  bf16x8 qf[4];
#pragma unroll
  for (int s = 0; s < 4; ++s) qf[s] = *(const bf16x8*)(qp + 8 * s);
  const float* gl = (const float*)(p.ws + E_GB) + grow * 24 + head * 3;
  const float g0 = 1.f / (1.f + __expf(-gl[0])), g1 = 1.f / (1.f + __expf(-gl[1])), g2 = 1.f / (1.f + __expf(-gl[2]));

  const bf16_t* Kc = (const bf16_t*)(p.ws + OFF_KCMP) + (size_t)bg * 128 * 64;
  const bf16_t* Vc = (const bf16_t*)(p.ws + OFF_VCMPT) + (size_t)bg * 64 * 128;
  const int ntile = (t0 >> 9) + 1;
  float m = NEG_INF, l = 0.f;
  bf16x8 kcur[4];
  load_kf(kcur, Kc, 64, 0, lane);
  for (int T = 0; T < ntile; ++T) {
    bf16x8 knxt[4];
    load_kf(knxt, Kc, 64, (T + 1 < ntile ? T + 1 : 0) * 32, lane);
    const f32x16 sa = qk_mfma(kcur, qf);
#pragma unroll
    for (int s = 0; s < 4; ++s) kcur[s] = knxt[s];
    float pv[16]; float mx = NEG_INF;
#pragma unroll
    for (int r = 0; r < 16; ++r) {
      const int c = T * 32 + 16 * (r >> 3) + 8 * h + (r & 7);
      const float v = (16 * c + 31 <= token) ? sa[r] * SC2 : NEG_INF;
      pv[r] = v; mx = fmaxf(mx, v);
    }
    mx = fmaxf(mx, __shfl_xor(mx, 32));
    const float mnew = fmaxf(m, mx), msafe = (mnew == NEG_INF) ? 0.f : mnew;
    const float alpha = ex2(m - msafe);
    float sum = 0.f;
#pragma unroll
    for (int r = 0; r < 16; ++r) sum += ex2(pv[r] - msafe);
    l = l * alpha + sum; m = mnew;
  }
  l = l + __shfl_xor(l, 32);
  const float invl = l > 0.f ? 1.f / l : 0.f, msafe = (m == NEG_INF) ? 0.f : m;
  f32x16 ot0, ot1;
  {
    f32x16 oc0, oc1;
#pragma unroll
    for (int r = 0; r < 16; ++r) { oc0[r] = 0.f; oc1[r] = 0.f; }
    for (int T = 0; T < ntile; ++T) {
      bf16x8 knxt[4];
      load_kf(knxt, Kc, 64, (T + 1 < ntile ? T + 1 : T) * 32, lane);
      bf16x8 vf[2][2];
      load_v(vf, Vc, 128, T * 32, lane);
      const f32x16 sa = qk_mfma(kcur, qf);
#pragma unroll
      for (int s = 0; s < 4; ++s) kcur[s] = knxt[s];
      float pv[16];
#pragma unroll
      for (int r = 0; r < 16; ++r) {
        const int c = T * 32 + 16 * (r >> 3) + 8 * h + (r & 7);
        pv[r] = (16 * c + 31 <= token) ? ex2(sa[r] * SC2 - msafe) * invl : 0.f;
      }
#pragma unroll
      for (int s2 = 0; s2 < 2; ++s2) {
        const int j0 = 8 * T + 4 * s2 + 2 * h;
        const float a0 = pv[8 * s2] + pv[8 * s2 + 1] + pv[8 * s2 + 2] + pv[8 * s2 + 3];
        const float a1 = pv[8 * s2 + 3] + pv[8 * s2 + 4] + pv[8 * s2 + 5] + pv[8 * s2 + 6] + pv[8 * s2 + 7];
        const float a2 = pv[8 * s2 + 7];
        float* ip = imp_s + (w * 32 + i) * 32 + j0;
        atomicAdd(ip, a0);
        atomicAdd(ip + 1, a1);
        if (j0 + 2 < 32) atomicAdd(ip + 2, a2);
      }
      bf16x8 pf[2];
      pack_p(pv, pf);
#pragma unroll
      for (int s2 = 0; s2 < 2; ++s2) { oc0 = MFMA(vf[0][s2], pf[s2], oc0); oc1 = MFMA(vf[1][s2], pf[s2], oc1); }
    }
#pragma unroll
    for (int r = 0; r < 16; ++r) { ot0[r] = g0 * oc0[r]; ot1[r] = g0 * oc1[r]; }
  }
  __syncthreads();
  const int tb = t0 >> 6;
  {
    const int q = tid >> 3, sub = tid & 7;
    float v[4];
#pragma unroll
    for (int jj = 0; jj < 4; ++jj) {
      const int j = sub * 4 + jj;
      const float im = imp_s[(0 * 32 + q) * 32 + j] + imp_s[(1 * 32 + q) * 32 + j] + imp_s[(2 * 32 + q) * 32 + j] + imp_s[(3 * 32 + q) * 32 + j];
      v[jj] = (j > tb) ? NEG_INF : ((j == 0 || j == tb || j == tb - 1) ? 1e4f : im);
    }
    unsigned msk = 0u;
#pragma unroll 1
    for (int rnd = 0; rnd < 8; ++rnd) {
      float best = NEG_INF; int bi = 99;
#pragma unroll
      for (int jj = 0; jj < 4; ++jj) if (v[jj] > best) { best = v[jj]; bi = sub * 4 + jj; }
#pragma unroll
      for (int o = 1; o < 8; o <<= 1) {
        const float ob = __shfl_xor(best, o); const int oi = __shfl_xor(bi, o);
        if (ob > best || (ob == best && oi < bi)) { best = ob; bi = oi; }
      }
      if (best > NEG_INF) {
        msk |= 1u << bi;
#pragma unroll
        for (int jj = 0; jj < 4; ++jj) if (sub * 4 + jj == bi) v[jj] = NEG_INF;
      }
    }
    if (sub == 0) sel_s[q] = msk;
  }
  __syncthreads();
  const unsigned sel = sel_s[i];
  {
    const bf16_t* Kp = (const bf16_t*)(p.ws + E_KS) + (size_t)b * S_ * 128 + g * 64;
    const bf16_t* Vp = (const bf16_t*)(p.ws + E_VST) + (size_t)bg * 64 * S_;
    Att st; att_init(st, NEG_INF, 0.f);
    MaskSel mf{sel, token, t0, 8 * h, 0, 0, true};
    att_stream(smem, st, qf, Kp, 128, Vp, S_, 0, tb, lane, mf);
    const float inv = att_invl(st) * g1;
#pragma unroll
    for (int r = 0; r < 16; ++r) { ot0[r] += inv * st.o0[r]; ot1[r] += inv * st.o1[r]; }
  }
  {
    const bf16_t* ow = (const bf16_t*)(p.ws + OFF_OWIN) + grow * 512 + head * 64 + 4 * h;
    u32x2 wv[8];
#pragma unroll
    for (int k = 0; k < 8; ++k) wv[k] = *(const u32x2*)(ow + 32 * (k >> 2) + 8 * (k & 3));
#pragma unroll
    for (int a = 0; a < 4; ++a) {
      ot0[4 * a] += bflo(wv[a][0]); ot0[4 * a + 1] += bfhi(wv[a][0]); ot0[4 * a + 2] += bflo(wv[a][1]); ot0[4 * a + 3] += bfhi(wv[a][1]);
      ot1[4 * a] += bflo(wv[4 + a][0]); ot1[4 * a + 1] += bfhi(wv[4 + a][0]); ot1[4 * a + 2] += bflo(wv[4 + a][1]); ot1[4 * a + 3] += bfhi(wv[4 + a][1]);
    }
  }
  store_out(ot0, ot1, (const bf16_t*)(p.ws + E_ZB) + grow * 512 + head * 64, (bf16_t*)(p.ws + OFF_H) + grow * 1024 + 512 + head * 64, h);
}

DI void kmean_unit(const Params& p, char* smem, int u) {
  float* red = (float*)smem;
  const int tid = tidx(), lane = tid & 63, w = tid >> 6;
  const int b = u >> 6, j = (u >> 3) & 7, cgp = u & 7, col = cgp * 128 + lane * 2;
  const bf16_t* kp = (const bf16_t*)(p.ws + O_K) + ((size_t)b * S_ + j * 256 + w * 64) * 1024 + col;
  float a0 = 0.f, a1 = 0.f;
#pragma unroll 8
  for (int t = 0; t < 64; ++t) { const unsigned v = *(const unsigned*)(kp + (size_t)t * 1024); a0 += bflo(v); a1 += bfhi(v); }
  __syncthreads();
  red[w * 128 + lane * 2] = a0; red[w * 128 + lane * 2 + 1] = a1;
  __syncthreads();
  if (tid < 128) {
    const float v = (red[tid] + red[128 + tid] + red[256 + tid] + red[384 + tid]) * (1.f / 256.f);
    const int c = cgp * 128 + tid, head = c >> 6, d = c & 63;
    ((float*)(p.ws + OFF_KMEAN))[(((size_t)b * 16 + head) * 8 + j) * 64 + d] = v;
  }
}
DI void moba_unit(const Params& p, char* smem, int li, int u) {
  const int lane = tidx() & 63, w = tidx() >> 6, i = lane & 31, h = lane >> 5;
  const int b = u >> 8, head = (u >> 4) & 15, chunk = u & 15, t0 = chunk * 128 + w * 32, token = t0 + i, ob = t0 >> 8;
  const size_t grow = (size_t)b * S_ + token;
  const bf16_t* qp = (const bf16_t*)(p.ws + O_Q) + grow * 1024 + head * 64 + 32 * h;
  bf16x8 qf[4];
#pragma unroll
  for (int s = 0; s < 4; ++s) qf[s] = *(const bf16x8*)(qp + 8 * s);
  const float* km = (const float*)(p.ws + OFF_KMEAN) + (size_t)li * 65536 + ((size_t)b * 16 + head) * 8 * 64 + 32 * h;
  float gs[7];
#pragma unroll
  for (int j = 0; j < 7; ++j) {
    float a = 0.f;
    if (j < ob) {
#pragma unroll
      for (int s = 0; s < 4; ++s) {
        const float4 k0 = *(const float4*)(km + j * 64 + 8 * s), k1 = *(const float4*)(km + j * 64 + 8 * s + 4);
        union { bf16x8 v; unsigned uu[4]; } t; t.v = qf[s];
        a += bflo(t.uu[0]) * k0.x + bfhi(t.uu[0]) * k0.y + bflo(t.uu[1]) * k0.z + bfhi(t.uu[1]) * k0.w;
        a += bflo(t.uu[2]) * k1.x + bfhi(t.uu[2]) * k1.y + bflo(t.uu[3]) * k1.z + bfhi(t.uu[3]) * k1.w;
      }
      a += __shfl_xor(a, 32);
    }
    gs[j] = a;
  }
  unsigned sel = 0u;
  if (ob <= 3) sel = (1u << ob) - 1u;
  else {
#pragma unroll
    for (int rnd = 0; rnd < 3; ++rnd) {
      float best = NEG_INF; int bi = 0;
#pragma unroll
      for (int j = 0; j < 7; ++j) if (j < ob && !((sel >> j) & 1u) && gs[j] > best) { best = gs[j]; bi = j; }
      sel |= 1u << bi;
    }
  }
  const bf16_t* Kp = (const bf16_t*)(p.ws + O_K) + (size_t)b * S_ * 1024 + head * 64;
  const bf16_t* Vp = (const bf16_t*)(p.ws + O_VT) + (size_t)(b * 16 + head) * 64 * S_;
  Att st; att_init(st, NEG_INF, 0.f);
  MaskMoba mf{sel, token, t0, ob, 8 * h, 0, 0, true};
  att_stream(smem, st, qf, Kp, 1024, Vp, S_, 0, chunk * 2 + 1, lane, mf);
  const float inv = att_invl(st);
#pragma unroll
  for (int r = 0; r < 16; ++r) { st.o0[r] *= inv; st.o1[r] *= inv; }
  store_out(st.o0, st.o1, (const bf16_t*)(p.ws + O_Z) + grow * 1024 + head * 64, (bf16_t*)(p.ws + OFF_H) + grow * 1024 + head * 64, h);
}

enum { PH_P0 = 0, PH_NORM, PH_G1, PH_E3, PH_E4, PH_E5, PH_O3, PH_O4, PH_OUT, PH_FINAL, PH_E4A };

typedef const Params __attribute__((address_space(4))) * KParamPtr;
DI void run_phase(char* smem, int ph, int layer, int vb, int nb) {
#if defined(__HIP_DEVICE_COMPILE__)
  KParamPtr kp = (KParamPtr)__builtin_amdgcn_kernarg_segment_ptr();
  asm volatile("" : "+s"(kp), "+s"(vb), "+s"(nb), "+s"(layer));
  Params p;
  __builtin_memcpy(&p, kp, sizeof(Params));
#else
  Params p{};
#endif
  const int li = layer >> 1;
  switch (ph) {
#if !defined(ONLY) || ONLY == 0
    case PH_P0: phase_p0(p, smem, vb, nb); break;
#endif
#if !defined(ONLY) || ONLY == 1
    case PH_NORM: phase_prep0(p, smem, vb, nb); break;
#endif
#if !defined(ONLY) || ONLY == 2
    case PH_G1: if (layer & 1) phase_g1_odd(p, smem, li, vb, nb); else phase_g1_even(p, smem, li, vb, nb); break;
#endif
#if !defined(ONLY) || ONLY == 3
    case PH_E3:
      if (nb > 256) {
        if (vb < 128) mlp1_tile(p, smem, li, vb);
        else for (int u = vb - 128; u < 1024; u += nb - 128) swa_unit(p, smem, li, u);
      } else {
        for (int u = vb; u < 128 + 1024; u += nb) { if (u < 128) mlp1_tile(p, smem, li, u); else swa_unit(p, smem, li, u - 128); }
      }
      break;
#endif
#if !defined(ONLY) || ONLY == 4
    case PH_E4:
      if (nb > 64) {
        if (vb < 32) mlp2_tile(p, smem, li, vb);
        else {
          const int W = nb - 32, vw = vb - 32;
          for (int r = 0; r * W < 1024; ++r) {
            const int k = r * W + ((r & 1) ? W - 1 - vw : vw);
            if (k < 1024) nsa_win_unit(p, smem, ((k & 15) << 6) | (63 - (k >> 4)));
          }
        }
      } else {
        for (int u = vb; u < 32; u += nb) mlp2_tile(p, smem, li, u);
        for (int k = vb; k < 1024; k += nb) nsa_win_unit(p, smem, ((k & 15) << 6) | (63 - (k >> 4)));
      }
      break;
#endif
#if !defined(ONLY) || ONLY == 5
    case PH_E5:
      for (int r = 0; r * nb < 1024; ++r) {
        const int idx = r * nb + ((r & 1) ? nb - 1 - vb : vb);
        if (idx >= 1024) continue;
        const int tt = 63 - (idx >> 4), bgi = idx & 15;
        nsa_unit(p, smem, (bgi << 6) | tt);
      }
      break;
#endif
#if !defined(ONLY) || ONLY == 6
    case PH_O3: for (int u = vb; u < 512; u += nb) kmean_unit(p, smem, u); break;
#endif
#if !defined(ONLY) || ONLY == 7
    case PH_O4:
      for (int r = 0; r * nb < 2048; ++r) {
        const int idx = r * nb + ((r & 1) ? nb - 1 - vb : vb);
        if (idx >= 2048) continue;
        const int chunk = 15 - (idx >> 7), bh = idx & 127;
        moba_unit(p, smem, li, (bh << 4) | chunk);
      }
      break;
#endif
#if !defined(ONLY) || ONLY == 8
    case PH_OUT: phase_out(p, smem, layer, vb, nb); break;
#endif
#if !defined(ONLY) || ONLY == 9
    case PH_FINAL: phase_final(p, vb, nb); break;
#endif
#if !defined(ONLY) || ONLY == 10
    case PH_E4A: break;
#endif
  }
}

constexpr int SMEM_BYTES = 55296;

template <int PH>
__global__ void __launch_bounds__(256, MINW) phase_kernel(Params p, int layer) {
  __shared__ __attribute__((aligned(16))) char smem[SMEM_BYTES];
  run_phase(smem, PH, layer, blockIdx.x, gridDim.x);
}

#define XB_TMO      128
#define XB_XCNT(j)  (256  + 64 * (j))
#define XB_XSUB(j)  (1280 + 64 * (j))
#define XB_XGEN(j)  (2304 + 64 * (j))
#define XB_TOP      3328
#define XB_TOPGEN   3392
#define XCD_BAR_WORDS 3456
#define XB_SPIN_CAP (1u << 18)
#define LAS __attribute__((address_space(3)))
DI unsigned xb_ld(unsigned* p) { return __hip_atomic_load(p, __ATOMIC_RELAXED, __HIP_MEMORY_SCOPE_AGENT); }
DI unsigned xb_add(unsigned* p, unsigned v) { return __hip_atomic_fetch_add(p, v, __ATOMIC_RELAXED, __HIP_MEMORY_SCOPE_AGENT); }
DI unsigned xb_xcc_id() { return (unsigned)__builtin_amdgcn_s_getreg((3 << 11) | 20) & 0xFu; }
#define XB_SPIN(cond, bar) do { unsigned _sp = 0; while (cond) { __builtin_amdgcn_s_sleep(1); \
    if ((++_sp & 255u) == 0u) { if (xb_ld(&(bar)[XB_TMO])) break; if (_sp > XB_SPIN_CAP) { atomicAdd(&(bar)[XB_TMO], 1u); break; } } } } while (0)
struct XcdBarrier { unsigned* bar; unsigned x; volatile LAS unsigned* st; };
DI XcdBarrier xcd_barrier_post(unsigned* bar, volatile LAS unsigned* st) {
  XcdBarrier b; b.bar = bar; b.x = xb_xcc_id(); b.st = st;
  if (threadIdx.x == 0) (void)xb_add(&bar[XB_XCNT(b.x)], 1u);
  return b;
}
DI void xcd_barrier_complete(unsigned* bar, unsigned x, unsigned& nloc, unsigned& nx) {
  const unsigned G = gridDim.x * gridDim.y * gridDim.z;
  unsigned sum, cnt, mine, sp = 0u;
  for (;;) {
    sum = 0u; cnt = 0u; mine = 0u;
#pragma unroll
    for (unsigned j = 0; j < 16; ++j) { const unsigned c = xb_ld(&bar[XB_XCNT(j)]); sum += c; cnt += (c > 0u) ? 1u : 0u; mine = (j == x) ? c : mine; }
    if (sum == G) break;
    __builtin_amdgcn_s_sleep(1);
    if ((++sp & 255u) == 0u) { if (xb_ld(&bar[XB_TMO])) break; if (sp > XB_SPIN_CAP) { atomicAdd(&bar[XB_TMO], 1u); break; } }
  }
  nloc = mine > 0u ? mine : 1u; nx = cnt > 0u ? cnt : 1u;
}
DI void xcd_barrier(const XcdBarrier& b) {
  asm volatile("s_waitcnt vmcnt(0)" ::: "memory");
  __syncthreads();
  if (threadIdx.x == 0) {
    unsigned* bar = b.bar;
    __builtin_amdgcn_s_waitcnt(0);
    unsigned nloc = b.st[0], nx = b.st[1];
    if (nloc == 0u) { xcd_barrier_complete(bar, b.x, nloc, nx); b.st[0] = nloc; b.st[1] = nx; }
    const unsigned old = xb_add(&bar[XB_XSUB(b.x)], 1u);
    const unsigned gen = old / nloc;
    if (old + 1u == (gen + 1u) * nloc) {
      __builtin_amdgcn_fence(__ATOMIC_RELEASE, "agent");
      asm volatile("s_waitcnt vmcnt(0)" ::: "memory");
      const unsigned og = xb_add(&bar[XB_TOP], 1u);
      const unsigned tg = og / nx;
      if (og + 1u == (tg + 1u) * nx) xb_add(&bar[XB_TOPGEN], 1u);
      else XB_SPIN(xb_ld(&bar[XB_TOPGEN]) == tg, bar);
      __builtin_amdgcn_fence(__ATOMIC_ACQUIRE, "agent");
      xb_add(&bar[XB_XGEN(b.x)], 1u);
      asm volatile("s_waitcnt vmcnt(0)" ::: "memory");
    } else {
      XB_SPIN(xb_ld(&bar[XB_XGEN(b.x)]) == gen, bar);
      __builtin_amdgcn_fence(__ATOMIC_ACQUIRE, "agent");
      asm volatile("s_waitcnt vmcnt(0)" ::: "memory");
    }
  }
  __syncthreads();
}

__global__ void __launch_bounds__(256, MINW) mega_kernel(Params p) {
  __shared__ __attribute__((aligned(16))) char smem[SMEM_BYTES];
  cg::grid_group grid = cg::this_grid();
  const int vb = blockIdx.x, nb = gridDim.x;
  __shared__ uint4 xb_words;
  unsigned* bar = (unsigned*)(p.ws + OFF_BAR);
  if (threadIdx.x == 0) xb_words = make_uint4(0u, 0u, 0u, 0u);
  if (vb == 0) for (int k = threadIdx.x; k < XCD_BAR_WORDS; k += 256) __hip_atomic_store(bar + k, 0u, __ATOMIC_RELAXED, __HIP_MEMORY_SCOPE_AGENT);
  __syncthreads();
  run_phase(smem, PH_P0, 0, vb, nb);
  if (PROBE_DUP & 2048) { __syncthreads(); run_phase(smem, PH_P0, 0, vb, nb); }
  grid.sync();
  const XcdBarrier xb = xcd_barrier_post(bar, (volatile LAS unsigned*)&xb_words);
#define GSYNC() xcd_barrier(xb)
  for (int layer = 0; layer < 4; ++layer) {
    if (layer == 0) { run_phase(smem, PH_NORM, layer, vb, nb); GSYNC(); if (PROBE_DUP & 4096) { run_phase(smem, PH_NORM, layer, vb, nb); GSYNC(); } }
    run_phase(smem, PH_G1, layer, vb, nb); GSYNC();
    if (PROBE_DUP & 1) { run_phase(smem, PH_G1, layer, vb, nb); GSYNC(); }
    if (layer & 1) {
      run_phase(smem, PH_O4, layer, vb, nb); GSYNC();
      if (PROBE_DUP & 4) { run_phase(smem, PH_O4, layer, vb, nb); GSYNC(); }
    } else {
      run_phase(smem, PH_E3, layer, vb, nb); GSYNC();
      if (PROBE_DUP & 8) { run_phase(smem, PH_E3, layer, vb, nb); GSYNC(); }
      run_phase(smem, PH_E4, layer, vb, nb); GSYNC();
      run_phase(smem, PH_E5, layer, vb, nb); GSYNC();
      if (PROBE_DUP & 2) { run_phase(smem, PH_E5, layer, vb, nb); GSYNC(); }
    }
    run_phase(smem, PH_OUT, layer, vb, nb); GSYNC();
    if ((PROBE_DUP & 32) && layer == 0) { for (int k = 0; k < 4; ++k) { run_phase(smem, PH_OUT, layer, vb, nb); GSYNC(); } }
  }
  if (PROBE_DUP & 64) { run_phase(smem, PH_P0, 0, vb, nb); GSYNC(); }
  if (PROBE_DUP & 128) { for (int k = 0; k < 20; ++k) GSYNC(); }
  if (PROBE_DUP & 256) { for (int k = 0; k < 4; ++k) { run_phase(smem, PH_O3, 1, vb, nb); GSYNC(); } }
#undef GSYNC
  run_phase(smem, PH_FINAL, 0, vb, nb);
}

extern "C" void kernel_launch(void* const* d_in, const int* in_sizes, int n_in, void* d_out, int out_size, void* d_ws, size_t ws_size,
                              hipStream_t stream) {
  Params p{};
  p.x = (const float*)d_in[0]; p.c = (const float*)d_in[1]; p.w_ada = (const float*)d_in[2]; p.b_ada = (const float*)d_in[3];
  p.norm_g = (const float*)d_in[4]; p.w_in_even = (const float*)d_in[5]; p.a_sinks = (const float*)d_in[6];
  p.pe_k = (const float*)d_in[7]; p.w1k = (const float*)d_in[8]; p.w2k = (const float*)d_in[9];
  p.pe_v = (const float*)d_in[10]; p.w1v = (const float*)d_in[11]; p.w2v = (const float*)d_in[12];
  p.w_out_even = (const float*)d_in[13]; p.w_in_odd = (const float*)d_in[14]; p.w_out_odd = (const float*)d_in[15];
  p.final_g = (const float*)d_in[16];
  p.out = (float*)d_out; p.ws = (char*)d_ws;
#if FUSED
  static int grid_blocks = 0;
  if (!grid_blocks) {
    int dev = 0, cus = 0, per_cu = 0;
    hipGetDevice(&dev);
    hipDeviceGetAttribute(&cus, hipDeviceAttributeMultiprocessorCount, dev);
    hipOccupancyMaxActiveBlocksPerMultiprocessor(&per_cu, mega_kernel, 256, 0);
    if (per_cu > 2) per_cu = 2;
    if (per_cu < 1) per_cu = 1;
    grid_blocks = cus * per_cu;
  }
  void* args[] = {&p};
  hipError_t e = hipLaunchCooperativeKernel((void*)mega_kernel, dim3(grid_blocks), dim3(256), args, 0, stream);
  if (e != hipSuccess) fprintf(stderr, "cooperative launch failed: %s (grid %d)\n", hipGetErrorString(e), grid_blocks);
#else
  const int G = 1024;
#define L(PH, layer) phase_kernel<PH><<<G, 256, 0, stream>>>(p, layer)
  L(PH_P0, 0);
  for (int layer = 0; layer < 4; ++layer) {
    if (layer == 0) L(PH_NORM, layer);
    L(PH_G1, layer); if (PROBE_DUP & 1) L(PH_G1, layer);
    if (layer & 1) { L(PH_O4, layer); if (PROBE_DUP & 4) L(PH_O4, layer); }
    else { L(PH_E3, layer); if (PROBE_DUP & 8) L(PH_E3, layer); L(PH_E4, layer); L(PH_E5, layer); if (PROBE_DUP & 2) L(PH_E5, layer); }
    L(PH_OUT, layer);
  }
  L(PH_FINAL, 0);
#undef L
#endif
}
```
